# Optimizing an MI355X kernel written in HIP

```python
import jax, jax.numpy as jnp
from jax import lax
import numpy as np

D_MODEL = 1024
BATCH = 32
SEQ = 256
DEPTH = 4
DEC_BATCH = 2
DEC_SEQ = 2048
PAST_LEN = 512

GRID_W = 64
HEAD_DIM = 64
ATTN_WIDTH = D_MODEL // 2
N_HEADS = ATTN_WIDTH // HEAD_DIM
N_KV_HEADS = 2
GROUP = N_HEADS // N_KV_HEADS
KV_WIDTH = N_KV_HEADS * HEAD_DIM
WINDOW = 128
BLOCK = 128
GM_WIDTH = D_MODEL // 4
GM_HEADS = 4
GM_DIM = GM_WIDTH // GM_HEADS
CHUNK = 128
POOL_WIDTH = D_MODEL // 4
POOL_WINDOWS = (2, 4, 8, 16)
POOL_DIM = POOL_WIDTH // len(POOL_WINDOWS)
MIX_WIDTH = ATTN_WIDTH + GM_WIDTH + POOL_WIDTH
IN_WIDTH = ATTN_WIDTH + 2 * KV_WIDTH + 2 * GM_WIDTH + POOL_WIDTH
SPLITS = (ATTN_WIDTH, ATTN_WIDTH + KV_WIDTH, ATTN_WIDTH + 2 * KV_WIDTH,
          ATTN_WIDTH + 2 * KV_WIDTH + GM_WIDTH, ATTN_WIDTH + 2 * KV_WIDTH + 2 * GM_WIDTH)
D_FF = 2816
N_MOD = 9
EPS = 1e-6
ROPE_BASE = 10000.0
NEG_INF = -1e30
ATTN_SCALE = HEAD_DIM ** -0.5

kernel_name = "hymba_macaron_prefix_dit_step"


def rms_norm(x, g):
    xf = x.astype(jnp.float32)
    y = xf * lax.rsqrt(jnp.mean(xf * xf, axis=-1, keepdims=True) + EPS)
    return (y * g.astype(jnp.float32)).astype(x.dtype)


def adaln(cvec, w_mod_l, b_mod_l):
    m = jax.nn.silu(cvec) @ w_mod_l + b_mod_l
    return m.reshape(cvec.shape[0], N_MOD, D_MODEL)


def modulate(h, mod, j):
    return h * (1 + mod[:, j + 1][:, None, :]) + mod[:, j][:, None, :]


def swiglu(h, w1, w2):
    g, u = jnp.split(h @ w1, 2, axis=-1)
    return (jax.nn.silu(g) * u) @ w2


def ffn_half(x, mod, j, g_pre, g_post, w1, w2):
    h = modulate(rms_norm(x, g_pre), mod, j)
    return x + 0.5 * mod[:, j + 2][:, None, :] * rms_norm(swiglu(h, w1, w2), g_post)


def axial_rope_tables(n_tok):
    rows = n_tok // GRID_W
    t = jnp.arange(rows * GRID_W, dtype=jnp.int32)
    row = (t // GRID_W).astype(jnp.float32)
    col = (t % GRID_W).astype(jnp.float32)
    nf = HEAD_DIM // 4
    inv = ROPE_BASE ** (-jnp.arange(nf, dtype=jnp.float32) / nf)
    ang = jnp.concatenate([row[:, None] * inv, col[:, None] * inv], axis=-1)
    return jnp.cos(ang), jnp.sin(ang)


def apply_axial_rope(x, cos, sin):
    S = x.shape[1]
    nf = HEAD_DIM // 4
    shape = (1, S) + (1,) * (x.ndim - 3) + (nf,)
    out = []
    for a in range(2):
        z = x[..., a * 2 * nf:(a + 1) * 2 * nf]
        z1, z2 = z[..., :nf], z[..., nf:]
        cs = cos[:, a * nf:(a + 1) * nf].reshape(shape).astype(x.dtype)
        sn = sin[:, a * nf:(a + 1) * nf].reshape(shape).astype(x.dtype)
        out += [z1 * cs - z2 * sn, z2 * cs + z1 * sn]
    return jnp.concatenate(out, axis=-1)


def sink_column(sink, lead_shape):
    s = sink.astype(jnp.float32).reshape(N_KV_HEADS, GROUP)[None, :, :, None, None]
    return jnp.broadcast_to(s, lead_shape + (1,))


def project(h, w_in):
    B, S, _ = h.shape
    q, k, v, gu, gv, pl = jnp.split(h @ w_in, SPLITS, axis=-1)
    q = q.reshape(B, S, N_KV_HEADS, GROUP, HEAD_DIM)
    k = k.reshape(B, S, N_KV_HEADS, HEAD_DIM)
    v = v.reshape(B, S, N_KV_HEADS, HEAD_DIM)
    return q, k, v, gu, gv, pl


def context_attention(q, k, v, sink):
    B, S = q.shape[:2]
    nblk = S // BLOCK
    qb = q.reshape(B, nblk, BLOCK, N_KV_HEADS, GROUP, HEAD_DIM).swapaxes(0, 1)

    def one(qblk):
        s = jnp.einsum('bqkgd,bskd->bkgqs', qblk, k).astype(jnp.float32) * ATTN_SCALE
        p = jax.nn.softmax(jnp.concatenate([s, sink_column(sink, s.shape[:-1])], axis=-1), axis=-1)
        return jnp.einsum('bkgqs,bskd->bqkgd', p[..., :-1].astype(v.dtype), v)

    o = lax.map(one, qb)
    return o.swapaxes(0, 1).reshape(B, S, ATTN_WIDTH)


def latent_attention(q, k, v, ck, cv, sink):
    B, S = q.shape[:2]
    nblk = S // BLOCK
    pad = ((0, 0), (BLOCK, BLOCK), (0, 0), (0, 0))
    kp = jnp.pad(k, pad)
    vp = jnp.pad(v, pad)
    qb = q.reshape(B, nblk, BLOCK, N_KV_HEADS, GROUP, HEAD_DIM).swapaxes(0, 1)
    qoff = jnp.arange(BLOCK, dtype=jnp.int32)
    koff = jnp.arange(3 * BLOCK, dtype=jnp.int32)
    n_band = 3 * BLOCK

    def one(args):
        i, qblk = args
        kb = lax.dynamic_slice_in_dim(kp, i * BLOCK, n_band, axis=1)
        vb = lax.dynamic_slice_in_dim(vp, i * BLOCK, n_band, axis=1)
        qpos = i * BLOCK + qoff
        kpos = i * BLOCK - BLOCK + koff
        valid = (kpos[None, :] >= 0) & (kpos[None, :] < S) & (jnp.abs(qpos[:, None] - kpos[None, :]) <= WINDOW)
        s_lat = jnp.einsum('bqkgd,bskd->bkgqs', qblk, kb).astype(jnp.float32) * ATTN_SCALE
        s_lat = jnp.where(valid, s_lat, NEG_INF)
        s_ctx = jnp.einsum('bqkgd,bckd->bkgqc', qblk, ck).astype(jnp.float32) * ATTN_SCALE
        p = jax.nn.softmax(jnp.concatenate([s_lat, s_ctx, sink_column(sink, s_lat.shape[:-1])], axis=-1), axis=-1)
        o = jnp.einsum('bkgqs,bskd->bqkgd', p[..., :n_band].astype(vb.dtype), vb)
        return o + jnp.einsum('bkgqc,bckd->bqkgd', p[..., n_band:-1].astype(cv.dtype), cv)

    o = lax.map(one, (jnp.arange(nblk, dtype=jnp.int32), qb))
    return o.swapaxes(0, 1).reshape(B, S, ATTN_WIDTH)


def chunk_gmlp(u, v, w_s, b_s):
    B, S, _ = v.shape
    n = S // CHUNK
    vh = v.reshape(B, n, CHUNK, GM_HEADS, GM_DIM).astype(jnp.float32)
    vh = (vh * lax.rsqrt(jnp.mean(vh * vh, axis=-1, keepdims=True) + EPS)).astype(v.dtype)
    z = jnp.einsum('hpq,bnqhd->bnphd', w_s, vh) + b_s.T[None, None, :, :, None]
    return u * z.reshape(B, S, GM_WIDTH)


def multiscale_pool(h, w_pool, scale):
    B, S, C = h.shape
    hf = h.astype(jnp.float32)
    cs = jnp.concatenate([jnp.zeros((B, 1, C), jnp.float32), jnp.cumsum(hf, axis=1)], axis=1)
    t = jnp.arange(S, dtype=jnp.int32)
    outs = []
    for g, w in enumerate(POOL_WINDOWS):
        lo = jnp.clip(t - w // 2, 0, S)
        hi = jnp.clip(t + w // 2, 0, S)
        cg = cs[..., g * POOL_DIM:(g + 1) * POOL_DIM]
        mean = (cg[:, hi] - cg[:, lo]) / (hi - lo).astype(jnp.float32)[None, :, None]
        d = (mean - hf[..., g * POOL_DIM:(g + 1) * POOL_DIM]).astype(h.dtype)
        outs.append(d @ w_pool[g])
    return jnp.concatenate(outs, axis=-1) * scale


def merge_heads(attn, gu, gv, pl, w_s, b_s, w_pool, pool_scale, w_out):
    a = chunk_gmlp(gu, gv, w_s, b_s)
    p = multiscale_pool(pl, w_pool, pool_scale)
    return jnp.concatenate([attn, a, p], axis=-1) @ w_out


def setup_inputs(seed: int = 0) -> dict:
    key = jax.random.key(seed)
    ks = jax.random.split(key, 18)
    f = jnp.float32
    nrm = lambda k, shape, s: jax.random.normal(k, shape, f) * s
    return {
        "x_prompt": nrm(ks[0], (BATCH, SEQ, D_MODEL), 1.0),
        "x_sample": nrm(ks[1], (DEC_BATCH, DEC_SEQ, D_MODEL), 1.0),
        "cache_k": nrm(ks[2], (DEC_BATCH, DEPTH, PAST_LEN, N_KV_HEADS, HEAD_DIM), 1.0),
        "cache_v": nrm(ks[3], (DEC_BATCH, DEPTH, PAST_LEN, N_KV_HEADS, HEAD_DIM), 1.0),
        "c": nrm(ks[4], (DEC_BATCH, D_MODEL), 1.0),
        "c_ctx": nrm(ks[5], (D_MODEL,), 1.0),
        "w_mod": nrm(ks[6], (DEPTH, D_MODEL, N_MOD * D_MODEL), 0.5 * D_MODEL ** -0.5),
        "b_mod": nrm(ks[7], (DEPTH, N_MOD * D_MODEL), 0.02),
        "norm_w": 1.0 + nrm(ks[8], (DEPTH, 6, D_MODEL), 0.02),
        "w_in": nrm(ks[9], (DEPTH, D_MODEL, IN_WIDTH), D_MODEL ** -0.5),
        "w_out": nrm(ks[10], (DEPTH, MIX_WIDTH, D_MODEL), MIX_WIDTH ** -0.5),
        "attn_sink": nrm(ks[11], (DEPTH, N_HEADS), 0.5),
        "w_spatial": nrm(ks[12], (DEPTH, GM_HEADS, CHUNK, CHUNK), CHUNK ** -0.5),
        "b_spatial": 1.0 + nrm(ks[13], (DEPTH, GM_HEADS, CHUNK), 0.02),
        "w_pool": nrm(ks[14], (DEPTH, len(POOL_WINDOWS), POOL_DIM, POOL_DIM), POOL_DIM ** -0.5),
        "pool_scale": 1.0 + nrm(ks[15], (DEPTH, POOL_WIDTH), 0.02),
        "ffn_w1": nrm(ks[16], (DEPTH, 2, D_MODEL, 2 * D_FF), D_MODEL ** -0.5),
        "ffn_w2": nrm(ks[17], (DEPTH, 2, D_FF, D_MODEL), D_FF ** -0.5),
    }


def reference(x_prompt, x_sample, cache_k, cache_v, c, c_ctx, w_mod, b_mod, norm_w, w_in, w_out,
              attn_sink, w_spatial, b_spatial, w_pool, pool_scale, ffn_w1, ffn_w2):
    y = x_prompt
    new_k, new_v = [], []
    for l in range(DEPTH):
        mod = adaln(c_ctx[None, :], w_mod[l], b_mod[l])
        y = ffn_half(y, mod, 0, norm_w[l, 0], norm_w[l, 1], ffn_w1[l, 0], ffn_w2[l, 0])
        h = modulate(rms_norm(y, norm_w[l, 2]), mod, 3)
        q, k, v, gu, gv, pl = project(h, w_in[l])
        attn = context_attention(q, k, v, attn_sink[l])
        out = merge_heads(attn, gu, gv, pl, w_spatial[l], b_spatial[l], w_pool[l], pool_scale[l], w_out[l])
        y = y + mod[:, 5][:, None, :] * rms_norm(out, norm_w[l, 3])
        y = ffn_half(y, mod, 6, norm_w[l, 4], norm_w[l, 5], ffn_w1[l, 1], ffn_w2[l, 1])
        new_k.append(k)
        new_v.append(v)
    y_prompt = y
    new_cache_k = jnp.stack(new_k, axis=1)
    new_cache_v = jnp.stack(new_v, axis=1)

    cos, sin = axial_rope_tables(x_sample.shape[1])
    z = x_sample
    for l in range(DEPTH):
        mod = adaln(c, w_mod[l], b_mod[l])
        z = ffn_half(z, mod, 0, norm_w[l, 0], norm_w[l, 1], ffn_w1[l, 0], ffn_w2[l, 0])
        h = modulate(rms_norm(z, norm_w[l, 2]), mod, 3)
        q, k, v, gu, gv, pl = project(h, w_in[l])
        q = apply_axial_rope(q, cos, sin)
        k = apply_axial_rope(k, cos, sin)
        attn = latent_attention(q, k, v, cache_k[:, l], cache_v[:, l], attn_sink[l])
        out = merge_heads(attn, gu, gv, pl, w_spatial[l], b_spatial[l], w_pool[l], pool_scale[l], w_out[l])
        z = z + mod[:, 5][:, None, :] * rms_norm(out, norm_w[l, 3])
        z = ffn_half(z, mod, 6, norm_w[l, 4], norm_w[l, 5], ffn_w1[l, 1], ffn_w2[l, 1])
    y_sample = z
    return (y_prompt, y_sample, new_cache_k, new_cache_v)
```

```cpp
#include <hip/hip_runtime.h>
#include <cstdio>
#include <cstdint>
namespace pg8 {
#define PG8_LAS __attribute__((address_space(3)))
typedef unsigned short bf16_t;
typedef short bf16x8 __attribute__((ext_vector_type(8)));
typedef float f32x4 __attribute__((ext_vector_type(4)));
typedef unsigned u32x4 __attribute__((ext_vector_type(4)));
constexpr int BM = 256, BK = 64, HALF = 128, HTB = HALF * BK * 2  , STAGE_BYTES = 8 * HTB, NXCD = 8, WGM = 8;

__host__ __device__ __forceinline__ int lds_byte(int r, int c) { const int st = (r >> 4) * 2 + (c >> 5), rr = r & 15, cc = c & 31, ob = rr * 64 + cc * 2; return st * 1024 + (ob ^ (((ob >> 9) & 1) << 5)); }
__host__ __device__ __forceinline__ void stage_rc(int b, int& R, int& C) { const int st = b / 1024, sb = b % 1024, swz = sb ^ (((sb >> 9) & 1) << 5); R = (st >> 1) * 16 + swz / 64; C = (st & 1) * 32 + (swz % 64) / 2; }
__host__ __device__ __forceinline__ int perm32(int rho) { const int n = rho >> 4, i = rho & 15; return 8 * (i >> 2) + 4 * n + (i & 3); }

struct Unit { int pm, pn; };
struct Gemm { const bf16_t* A; const bf16_t* Bt; int M, N, K; };

struct StaticOrder {
    int nM, nN, nwg, G, c;
    __host__ __device__ void init(int M, int N, int G_, int c_) { nM = M / BM; nN = N / BM; nwg = nM * nN; G = G_; c = c_; }
    __host__ __device__ bool next(int i, Unit& u) const {
        const long L = (long)i * G + c; if (L >= nwg) return false;
        int wgid = (int)L; { const int q = nwg / NXCD, r = nwg % NXCD, xcd = wgid % NXCD, off = wgid / NXCD; wgid = (xcd < r ? xcd * (q + 1) : r * (q + 1) + (xcd - r) * q) + off; }
        const int nig = WGM * nN, gid = wgid / nig, fm = gid * WGM, gsz = (nM - fm) < WGM ? (nM - fm) : WGM;
        u.pm = fm + ((wgid % nig) % gsz); u.pn = (wgid % nig) / gsz; return true;
    }
    __device__ __forceinline__ void a_ready(const Unit&) const {}
    __device__ __forceinline__ void done(const Unit&) const {}
};

__device__ __forceinline__ unsigned cvt_pk_bf16(float lo, float hi) { unsigned r; asm volatile("v_cvt_pk_bf16_f32 %0, %1, %2" : "=v"(r) : "v"(lo), "v"(hi)); return r; }
struct EpiF32 {
    static constexpr bool PERM = false, AFTER_DRAIN = false;
    float* C; int ldc;
    __device__ __forceinline__ void operator()(const f32x4 (&acc)[2][2][4][2], const Unit& u, int wr, int wc, int fr, int fq) const {
        const int row0 = u.pm * BM + wr * 64 + fr, col0 = u.pn * BM + wc * 32 + 4 * fq;
#pragma unroll
        for (int ai = 0; ai < 2; ++ai)
#pragma unroll
            for (int m = 0; m < 4; ++m) { float* rowp = C + (size_t)(row0 + ai * HALF + m * 16) * ldc + col0;
#pragma unroll
                for (int bj = 0; bj < 2; ++bj)
#pragma unroll
                    for (int n = 0; n < 2; ++n) *(f32x4*)(rowp + bj * HALF + n * 16) = acc[ai][bj][m][n]; }
    }
};
struct EpiBf16P {
    static constexpr bool PERM = true, AFTER_DRAIN = false;
    bf16_t* O; int ldc;
    __device__ __forceinline__ void operator()(const f32x4 (&acc)[2][2][4][2], const Unit& u, int wr, int wc, int fr, int fq) const {
        const int row0 = u.pm * BM + wr * 64 + fr, col0 = u.pn * BM + wc * 32 + 8 * fq;
#pragma unroll
        for (int ai = 0; ai < 2; ++ai)
#pragma unroll
            for (int m = 0; m < 4; ++m) { bf16_t* rowp = O + (size_t)(row0 + ai * HALF + m * 16) * ldc + col0;
#pragma unroll
                for (int bj = 0; bj < 2; ++bj) { const f32x4 v0 = acc[ai][bj][m][0], v1 = acc[ai][bj][m][1];
                    u32x4 w; w.x = cvt_pk_bf16(v0[0], v0[1]); w.y = cvt_pk_bf16(v0[2], v0[3]); w.z = cvt_pk_bf16(v1[0], v1[1]); w.w = cvt_pk_bf16(v1[2], v1[3]);
                    *(u32x4*)(rowp + bj * HALF) = w; } }
    }
};
__device__ __forceinline__ float silu_mul(float g, float u) { return g * __builtin_amdgcn_rcpf(1.0f + __builtin_amdgcn_exp2f(-1.4426950408889634f * g)) * u; }
struct EpiSwiglu {
    static constexpr bool PERM = true, AFTER_DRAIN = false;
    bf16_t* O; int ldc;
    __device__ __forceinline__ void operator()(const f32x4 (&acc)[2][2][4][2], const Unit& u, int wr, int wc, int fr, int fq) const {
        const int row0 = u.pm * BM + wr * 64 + fr, col0 = u.pn * HALF + wc * 32 + 8 * fq;
#pragma unroll
        for (int ai = 0; ai < 2; ++ai)
#pragma unroll
            for (int m = 0; m < 4; ++m) { bf16_t* rowp = O + (size_t)(row0 + ai * HALF + m * 16) * ldc + col0;
                const f32x4 g0 = acc[ai][0][m][0], g1 = acc[ai][0][m][1], u0 = acc[ai][1][m][0], u1 = acc[ai][1][m][1];
                u32x4 w; w.x = cvt_pk_bf16(silu_mul(g0[0], u0[0]), silu_mul(g0[1], u0[1])); w.y = cvt_pk_bf16(silu_mul(g0[2], u0[2]), silu_mul(g0[3], u0[3]));
                w.z = cvt_pk_bf16(silu_mul(g1[0], u1[0]), silu_mul(g1[1], u1[1])); w.w = cvt_pk_bf16(silu_mul(g1[2], u1[2]), silu_mul(g1[3], u1[3]));
                *(u32x4*)rowp = w; }
    }
};

template <class Epi, class Sched, bool ALIGN_EPI = false, bool SP2 = false>
__device__ __forceinline__ void gemm_phase(PG8_LAS unsigned char* lds, const Gemm g, const Sched& S, const Epi& E) {
    int tid_ = threadIdx.x; asm volatile("" : "+v"(tid_));
    const int tid = tid_, wid = __builtin_amdgcn_readfirstlane(tid >> 6), lane = tid & 63, wr = wid >> 2, wc = wid & 3, fr = lane & 15, fq = lane >> 4;
    const int K = g.K, nt = K / BK;
    unsigned voffA[2], voffB[2];
#pragma unroll
    for (int i = 0; i < 2; ++i) { int R, C; stage_rc(tid * 16 + i * 8192, R, C); const int Rb = Epi::PERM ? ((R & ~31) + perm32(R & 31)) : R;
        voffA[i] = (unsigned)(R * K + C) * 2u; voffB[i] = (unsigned)(Rb * K + C) * 2u; }
    const size_t kstep = (size_t)(BK * 2);
    const size_t hstep = (size_t)HALF * K * 2;
    const size_t tstep = 2 * hstep;
    const unsigned ldsw = (unsigned)wid * 1024u;
    const int aoff = lds_byte(wr * 64 + fr, fq * 8), boff = lds_byte(wc * 32 + fr, fq * 8);
#define PG8_SA(b, h) (((b) * 2 + (h)) * HTB)
#define PG8_SB(b, h) ((4 + (b) * 2 + (h)) * HTB)
#define PG8_STAGE(bufoff, gbase, voff) do { _Pragma("unroll") for (int _i = 0; _i < 2; ++_i) \
        __builtin_amdgcn_global_load_lds((const unsigned*)((const char*)(gbase) + (voff)[_i]), (PG8_LAS unsigned*)(lds + (bufoff) + ldsw + _i * 8192), 16, 0, 0); } while (0)
#define PG8_LDA(dst, b, h) do { _Pragma("unroll") for (int m = 0; m < 4; ++m) _Pragma("unroll") for (int k = 0; k < 2; ++k) dst[m][k] = *(const PG8_LAS bf16x8*)(lds + PG8_SA(b, h) + aoff + m * 2048 + k * 1024); } while (0)
#define PG8_LDB(dst, b, h) do { _Pragma("unroll") for (int n = 0; n < 2; ++n) _Pragma("unroll") for (int k = 0; k < 2; ++k) dst[n][k] = *(const PG8_LAS bf16x8*)(lds + PG8_SB(b, h) + boff + n * 2048 + k * 1024); } while (0)
#define PG8_MMA(ai, bj, At, Bt) do { __builtin_amdgcn_s_setprio(1); _Pragma("unroll") for (int m = 0; m < 4; ++m) _Pragma("unroll") for (int n = 0; n < 2; ++n) _Pragma("unroll") for (int k = 0; k < 2; ++k) \
        acc[ai][bj][m][n] = __builtin_amdgcn_mfma_f32_16x16x32_bf16(Bt[n][k], At[m][k], acc[ai][bj][m][n], 0, 0, 0); __builtin_amdgcn_s_setprio(0); } while (0)
#define PG8_WAIT_V(n) asm volatile("s_waitcnt vmcnt(" #n ")" ::: "memory")
#define PG8_WAIT_L(n) asm volatile("s_waitcnt lgkmcnt(" #n ")" ::: "memory")
#define PG8_BAR __builtin_amdgcn_s_barrier()
#define PG8_SCHED __builtin_amdgcn_sched_barrier(0)
    Unit cur, nxt; int ui = 0;
    if (!S.next(0, cur)) return;
    f32x4 acc[2][2][4][2];
#pragma unroll
    for (int a = 0; a < 2; ++a)
#pragma unroll
        for (int b = 0; b < 2; ++b)
#pragma unroll
            for (int m = 0; m < 4; ++m)
#pragma unroll
                for (int n = 0; n < 2; ++n) acc[a][b][m][n] = (f32x4){0.f, 0.f, 0.f, 0.f};
    bf16x8 At[4][2], B0[2][2], B1[2][2];
    const char* cA = (const char*)g.A + (size_t)cur.pm * tstep; const char* cB = (const char*)g.Bt + (size_t)cur.pn * tstep;
    S.a_ready(cur);
    if constexpr (SP2) {
        PG8_STAGE(PG8_SB(0, 0), cB, voffB); PG8_STAGE(PG8_SB(0, 1), cB + hstep, voffB); PG8_STAGE(PG8_SA(0, 0), cA, voffA); PG8_STAGE(PG8_SA(0, 1), cA + hstep, voffA);
        if (wr == 1) PG8_BAR;
        PG8_WAIT_V(2); PG8_BAR;
        PG8_STAGE(PG8_SB(1, 0), cB + kstep, voffB); PG8_STAGE(PG8_SA(1, 0), cA + kstep, voffA); PG8_STAGE(PG8_SB(1, 1), cB + hstep + kstep, voffB);
        PG8_WAIT_V(6); PG8_BAR;
    } else {
        PG8_STAGE(PG8_SB(0, 0), cB, voffB); PG8_STAGE(PG8_SA(0, 0), cA, voffA); PG8_STAGE(PG8_SB(0, 1), cB + hstep, voffB); PG8_STAGE(PG8_SA(0, 1), cA + hstep, voffA);
        if (wr == 1) PG8_BAR;
        PG8_WAIT_V(4); PG8_BAR;
        PG8_STAGE(PG8_SB(1, 0), cB + kstep, voffB); PG8_STAGE(PG8_SA(1, 0), cA + kstep, voffA); PG8_STAGE(PG8_SB(1, 1), cB + hstep + kstep, voffB);
        PG8_WAIT_V(6); PG8_BAR;
    }
    for (;;) {
        const bool has_next = S.next(ui + 1, nxt);
        const char* nA = has_next ? (const char*)g.A + (size_t)nxt.pm * tstep : cA; const char* nB = has_next ? (const char*)g.Bt + (size_t)nxt.pn * tstep : cB;
        for (int t = 0; t < nt; t += 2) {
            const bool last = (t == nt - 2);
            const char* a1 = cA + (size_t)(t + 1) * kstep;
            const char* a2 = last ? nA : cA + (size_t)(t + 2) * kstep; const char* b2 = last ? nB : cB + (size_t)(t + 2) * kstep;
            const char* a3 = a2 + kstep; const char* b3 = b2 + kstep;
            if (last && has_next) S.a_ready(nxt);
            if constexpr (SP2) {
            PG8_LDB(B0, 0, 0); PG8_LDB(B1, 0, 1); PG8_SCHED; PG8_LDA(At, 0, 0); PG8_STAGE(PG8_SA(1, 1), a1 + hstep, voffA);
            PG8_WAIT_V(8); PG8_WAIT_L(0); PG8_BAR; PG8_MMA(0, 0, At, B0); PG8_MMA(0, 1, At, B1); PG8_BAR; PG8_SCHED;
            PG8_LDA(At, 0, 1); PG8_STAGE(PG8_SB(0, 0), b2, voffB); PG8_STAGE(PG8_SB(0, 1), b2 + hstep, voffB); PG8_STAGE(PG8_SA(0, 0), a2, voffA);
            PG8_WAIT_V(8); PG8_WAIT_L(0); PG8_BAR; PG8_MMA(1, 0, At, B0); PG8_MMA(1, 1, At, B1); PG8_BAR; PG8_SCHED;
            PG8_LDB(B0, 1, 0); PG8_LDB(B1, 1, 1); PG8_SCHED; PG8_LDA(At, 1, 0); PG8_STAGE(PG8_SA(0, 1), a2 + hstep, voffA);
            PG8_WAIT_V(8); PG8_WAIT_L(0); PG8_BAR; PG8_MMA(0, 0, At, B0); PG8_MMA(0, 1, At, B1); PG8_BAR; PG8_SCHED;
            PG8_LDA(At, 1, 1); PG8_STAGE(PG8_SB(1, 0), b3, voffB); PG8_STAGE(PG8_SB(1, 1), b3 + hstep, voffB); PG8_STAGE(PG8_SA(1, 0), a3, voffA);
            PG8_WAIT_V(8); PG8_WAIT_L(0); PG8_BAR; PG8_MMA(1, 0, At, B0); PG8_MMA(1, 1, At, B1); PG8_BAR; PG8_SCHED;
            } else {
            PG8_LDB(B0, 0, 0); PG8_SCHED; PG8_LDA(At, 0, 0); PG8_STAGE(PG8_SA(1, 1), a1 + hstep, voffA);
            PG8_WAIT_L(8); PG8_BAR; PG8_WAIT_L(0); PG8_MMA(0, 0, At, B0); PG8_BAR; PG8_SCHED;
            PG8_LDB(B1, 0, 1); PG8_STAGE(PG8_SB(0, 0), b2, voffB);
            PG8_BAR; PG8_WAIT_L(0); PG8_MMA(0, 1, At, B1); PG8_BAR;
            PG8_LDA(At, 0, 1); PG8_STAGE(PG8_SA(0, 0), a2, voffA);
            PG8_BAR; PG8_WAIT_L(0); PG8_MMA(1, 0, At, B0); PG8_BAR; PG8_SCHED;
            PG8_STAGE(PG8_SB(0, 1), b2 + hstep, voffB);
            PG8_WAIT_V(6); PG8_BAR; PG8_MMA(1, 1, At, B1); PG8_BAR;
            PG8_LDB(B0, 1, 0); PG8_SCHED; PG8_LDA(At, 1, 0); PG8_STAGE(PG8_SA(0, 1), a2 + hstep, voffA);
            PG8_WAIT_L(8); PG8_BAR; PG8_WAIT_L(0); PG8_MMA(0, 0, At, B0); PG8_BAR; PG8_SCHED;
            PG8_LDB(B1, 1, 1); PG8_STAGE(PG8_SB(1, 0), b3, voffB);
            PG8_BAR; PG8_WAIT_L(0); PG8_MMA(0, 1, At, B1); PG8_BAR;
            PG8_LDA(At, 1, 1); PG8_STAGE(PG8_SA(1, 0), a3, voffA);
            PG8_BAR; PG8_WAIT_L(0); PG8_MMA(1, 0, At, B0); PG8_BAR; PG8_SCHED;
            PG8_STAGE(PG8_SB(1, 1), b3 + hstep, voffB);
            PG8_WAIT_V(6); PG8_BAR; PG8_MMA(1, 1, At, B1); PG8_BAR;
            }
        }
        if constexpr (ALIGN_EPI) { if (wr == 0) PG8_BAR; }
        if constexpr (!Epi::AFTER_DRAIN) { E(acc, cur, wr, wc, fr, fq); S.done(cur); }
        if (!has_next) break;
#pragma unroll
        for (int a = 0; a < 2; ++a)
#pragma unroll
            for (int b = 0; b < 2; ++b)
#pragma unroll
                for (int m = 0; m < 4; ++m)
#pragma unroll
                    for (int n = 0; n < 2; ++n) acc[a][b][m][n] = (f32x4){0.f, 0.f, 0.f, 0.f};
        cur = nxt; cA = nA; cB = nB; ++ui;
        if constexpr (ALIGN_EPI) { if (wr == 1) PG8_BAR; }
    }
    PG8_WAIT_V(0);
    if constexpr (!ALIGN_EPI) { if (wr == 0) PG8_BAR; }
    PG8_BAR;
    if constexpr (Epi::AFTER_DRAIN) { E.fused(acc, cur, wr, wc, fr, fq, lds, wid, lane); S.done(cur); }
#undef PG8_SA
#undef PG8_SB
#undef PG8_STAGE
#undef PG8_LDA
#undef PG8_LDB
#undef PG8_MMA
#undef PG8_WAIT_V
#undef PG8_WAIT_L
#undef PG8_BAR
#undef PG8_SCHED
}
}

#define GAS __attribute__((address_space(1)))
#define LAS __attribute__((address_space(3)))
typedef unsigned short bf16;
typedef unsigned v4u __attribute__((ext_vector_type(4)));
typedef float f32x4 __attribute__((ext_vector_type(4)));
typedef short bf16x8 __attribute__((ext_vector_type(8)));
typedef GAS unsigned gu32;
typedef GAS unsigned long long gu64;
#define RLX_AGENT __ATOMIC_RELAXED, __HIP_MEMORY_SCOPE_AGENT
#define LDS_WAIT() asm volatile("s_waitcnt lgkmcnt(0)" ::: "memory")
#define VM_WAIT() asm volatile("s_waitcnt vmcnt(0)" ::: "memory")
__device__ __forceinline__ unsigned long long rt() { return __builtin_amdgcn_s_memrealtime(); }
__device__ __forceinline__ unsigned f2bf(float f) { unsigned u = __builtin_bit_cast(unsigned, f); return (u + 0x7fffu + ((u >> 16) & 1u)) >> 16; }
__device__ __forceinline__ unsigned pk2(float lo, float hi) { return f2bf(lo) | (f2bf(hi) << 16); }

#define XB_TMO      128
#define XB_XCNT(j)  (256  + 64 * (j))
#define XB_XSUB(j)  (1280 + 64 * (j))
#define XB_XGEN(j)  (2304 + 64 * (j))
#define XB_TOP      3328
#define XB_TOPGEN   3392
#define XCD_BAR_WORDS 3456
#define XB_SPIN_CAP (1u << 18)

__device__ __forceinline__ unsigned xb_ld(unsigned* p)              { return __hip_atomic_load(p, __ATOMIC_RELAXED, __HIP_MEMORY_SCOPE_AGENT); }
__device__ __forceinline__ unsigned xb_add(unsigned* p, unsigned v) { return __hip_atomic_fetch_add(p, v, __ATOMIC_RELAXED, __HIP_MEMORY_SCOPE_AGENT); }
__device__ __forceinline__ unsigned xb_xcc_id() { return (unsigned)__builtin_amdgcn_s_getreg((3 << 11) | 20) & 0xFu; }
#define XB_SPIN(cond, bar) do { unsigned _sp = 0; while (cond) { __builtin_amdgcn_s_sleep(1); \
    if ((++_sp & 255u) == 0u) { if (xb_ld(&(bar)[XB_TMO])) break; if (_sp > XB_SPIN_CAP) { atomicAdd(&(bar)[XB_TMO], 1u); break; } } } } while (0)

struct XcdBarrier {
    unsigned* bar; unsigned x;
    volatile LAS unsigned* st;
};

__device__ __forceinline__ XcdBarrier xcd_barrier_post(unsigned* bar, volatile LAS unsigned* st) {
    XcdBarrier b; b.bar = bar; b.x = xb_xcc_id(); b.st = st;
    if (threadIdx.x == 0) (void)xb_add(&bar[XB_XCNT(b.x)], 1u);
    return b;
}
__device__ __forceinline__ void xcd_barrier_complete(unsigned* bar, unsigned x, unsigned& nloc, unsigned& nx) {
    const unsigned G = gridDim.x * gridDim.y * gridDim.z;
    unsigned sum, cnt, mine, sp = 0u;
    for (;;) {
        sum = 0u; cnt = 0u; mine = 0u;
#pragma unroll
        for (unsigned j = 0; j < 16; ++j) { const unsigned c = xb_ld(&bar[XB_XCNT(j)]); sum += c; cnt += (c > 0u) ? 1u : 0u; mine = (j == x) ? c : mine; }
        if (sum == G) break;
        __builtin_amdgcn_s_sleep(1);
        if ((++sp & 255u) == 0u) { if (xb_ld(&bar[XB_TMO])) break; if (sp > XB_SPIN_CAP) { atomicAdd(&bar[XB_TMO], 1u); break; } }
    }
    nloc = mine > 0u ? mine : 1u; nx = cnt > 0u ? cnt : 1u;
}

__device__ __forceinline__ void xcd_barrier(const XcdBarrier& b) {
    asm volatile("s_waitcnt vmcnt(0)" ::: "memory");
    __syncthreads();
    if (threadIdx.x == 0) {
        unsigned* bar = b.bar;
        __builtin_amdgcn_s_waitcnt(0);
        unsigned nloc = b.st[0], nx = b.st[1];
        if (nloc == 0u) { xcd_barrier_complete(bar, b.x, nloc, nx); b.st[0] = nloc; b.st[1] = nx; }
        const unsigned old = xb_add(&bar[XB_XSUB(b.x)], 1u);
        const unsigned gen = old / nloc;
        if (old + 1u == (gen + 1u) * nloc) {
            __builtin_amdgcn_fence(__ATOMIC_RELEASE, "agent");
            asm volatile("s_waitcnt vmcnt(0)" ::: "memory");
            const unsigned og = xb_add(&bar[XB_TOP], 1u);
            const unsigned tg = og / nx;
            if (og + 1u == (tg + 1u) * nx) xb_add(&bar[XB_TOPGEN], 1u);
            else XB_SPIN(xb_ld(&bar[XB_TOPGEN]) == tg, bar);
            __builtin_amdgcn_fence(__ATOMIC_ACQUIRE, "agent");
            xb_add(&bar[XB_XGEN(b.x)], 1u);
            asm volatile("s_waitcnt vmcnt(0)" ::: "memory");
        } else {
            XB_SPIN(xb_ld(&bar[XB_XGEN(b.x)]) == gen, bar);
            __builtin_amdgcn_fence(__ATOMIC_ACQUIRE, "agent");
            asm volatile("s_waitcnt vmcnt(0)" ::: "memory");
        }
    }
    __syncthreads();
}

constexpr int NWAVES = 8;
#ifndef MK_N_LAUNCHES
#define MK_N_LAUNCHES 1
#endif
#ifndef MK_NAIVE_MIX
#define MK_NAIVE_MIX 1
#endif

constexpr int D = 1024, DEPTH = 4, DFF = 2816, NIN = 1536, NMOD = 9;
constexpr int M_CTX = 32 * 256, M_LAT = 2 * 2048, M = M_CTX + M_LAT;
constexpr int SEQ_C = 256, SEQ_L = 2048, PAST = 512;
constexpr float EPS = 1e-6f;
constexpr int NPHASE = 2 + 10 * DEPTH;
constexpr int N_LAUNCHES = (MK_N_LAUNCHES == 1) ? 1 : NPHASE;

constexpr size_t MiB = 1u << 20;
constexpr size_t WS_CTL = 0, CTL_ZERO_BYTES = 1 * MiB;
constexpr size_t WS_MOD = 1 * MiB;
constexpr size_t WS_ROPE = 2 * MiB;
constexpr size_t WS_W1T = 4 * MiB;
constexpr size_t WS_W2T = 92 * MiB;
constexpr size_t WS_WIN = 136 * MiB;
constexpr size_t WS_WOUT = 148 * MiB;
constexpr size_t WS_H = 156 * MiB;
constexpr size_t WS_A = 180 * MiB;
constexpr size_t WS_O = 246 * MiB;
constexpr size_t WS_QKV = 294 * MiB;
constexpr size_t WS_MIX = 330 * MiB;
constexpr size_t WS_END = 354 * MiB;
constexpr int CW_BAR = 4096;

constexpr int RING_OFF = 0, RING_BYTES = 131072;
constexpr int LDSCTL_OFF = RING_BYTES, MISC_OFF = LDSCTL_OFF + 320;
constexpr int LDS_BYTES = 147456;

__device__ __forceinline__ float bf2f(unsigned short v) { return __uint_as_float((unsigned)v << 16); }
__device__ __forceinline__ float wave_sum(float v) {
#pragma unroll
    for (int o = 1; o < 64; o <<= 1) v += __shfl_xor(v, o);
    return v;
}
__device__ __forceinline__ float wave_max(float v) {
#pragma unroll
    for (int o = 1; o < 64; o <<= 1) v = fmaxf(v, __shfl_xor(v, o));
    return v;
}

struct Frame {
    LAS unsigned char* lds;
    int tid, lane, wave, vcu, G;
    unsigned char* ws; float* out;
};
__device__ __forceinline__ void frame_refresh(Frame& F) {
    int t_ = threadIdx.x, b_ = blockIdx.x; asm volatile("" : "+v"(t_)); asm volatile("" : "+s"(b_));
    F.tid = t_; F.lane = t_ & 63; F.wave = __builtin_amdgcn_readfirstlane(t_ >> 6);
    F.G = gridDim.x; F.vcu = (F.G % 8 == 0) ? (b_ % 8) * (F.G / 8) + b_ / 8 : b_;
}
typedef __attribute__((address_space(4))) const unsigned char* kargp_t;
template <int I> __device__ __forceinline__ const float* inp() {
    kargp_t kp = (kargp_t)__builtin_amdgcn_kernarg_segment_ptr(); unsigned long long v;
    asm volatile("s_load_dwordx2 %0, %1, %2\n\ts_waitcnt lgkmcnt(0)" : "=s"(v) : "s"(kp), "i"(8 * I) : "memory");
    return (const float*)v;
}
enum { I_XP = 0, I_XS, I_CK, I_CV, I_C, I_CCTX, I_WMOD, I_BMOD, I_NORMW, I_WIN, I_WOUT, I_SINK, I_WSP, I_BSP, I_WPOOL, I_PSCALE, I_W1, I_W2 };
#define P_MOD(F)  ((float*)((F).ws + WS_MOD))
#define P_ROPEC(F) ((float*)((F).ws + WS_ROPE))
#define P_ROPES(F) ((float*)((F).ws + WS_ROPE) + SEQ_L * 32)
#define P_O(F)    ((float*)((F).ws + WS_O))
#define P_W1T(F)  ((bf16*)((F).ws + WS_W1T))
#define P_W2T(F)  ((bf16*)((F).ws + WS_W2T))
#define P_WIN(F)  ((bf16*)((F).ws + WS_WIN))
#define P_WOUT(F) ((bf16*)((F).ws + WS_WOUT))
#define P_H(F)    ((bf16*)((F).ws + WS_H))
#define P_A(F)    ((bf16*)((F).ws + WS_A))
#define P_QKV(F)  ((bf16*)((F).ws + WS_QKV))
#define P_MIX(F)  ((bf16*)((F).ws + WS_MIX))

__device__ const double ROPE_INV[16] = {1.0, 0.5623413251903491, 0.31622776601683794, 0.1778279410038923, 0.1, 0.05623413251903491, 0.03162277660168379, 0.01778279410038923,
                                        0.01, 0.005623413251903491, 0.0031622776601683794, 0.0017782794100389228, 0.001, 0.0005623413251903491, 0.00031622776601683794, 0.00017782794100389227};
__device__ __forceinline__ void sincos_d(double x, double& s, double& c) {
    const double kd = __builtin_rint(x * 0.63661977236758134308); const int k = (int)kd;
    double r = __builtin_fma(-kd, 1.57079632679489655800e+00, x); r = __builtin_fma(-kd, 6.12323399573676603587e-17, r);
    const double r2 = r * r;
    const double sp = r * (1.0 + r2 * (-1.0 / 6 + r2 * (1.0 / 120 + r2 * (-1.0 / 5040 + r2 * (1.0 / 362880 + r2 * (-1.0 / 39916800 + r2 * (1.0 / 6227020800.0)))))));
    const double cp = 1.0 + r2 * (-0.5 + r2 * (1.0 / 24 + r2 * (-1.0 / 720 + r2 * (1.0 / 40320 + r2 * (-1.0 / 3628800 + r2 * (1.0 / 479001600 + r2 * (-1.0 / 87178291200.0)))))));
    switch (k & 3) { case 0: s = sp; c = cp; break; case 1: s = cp; c = -sp; break; case 2: s = -sp; c = -cp; break; default: s = -cp; c = sp; break; }
}
__device__ __forceinline__ void phase_mod(Frame& F) {
    frame_refresh(F);
    const float* c_ctx = inp<I_CCTX>(); const float* cvec = inp<I_C>(); const float* w_mod = inp<I_WMOD>(); const float* b_mod = inp<I_BMOD>();
    float* modp = P_MOD(F); float* ropec = P_ROPEC(F); float* ropes = P_ROPES(F);
    LAS float* sil = (LAS float*)F.lds;
    LAS float* part = (LAS float*)(F.lds + 16384);
    for (int i = F.tid; i < 3 * D; i += NWAVES * 64) { const int b = i >> 10, k = i & 1023; const float cv = (b == 0) ? c_ctx[k] : cvec[(b - 1) * D + k]; sil[i] = cv / (1.0f + expf(-cv)); }
    __syncthreads();
    const int ct = F.tid & 15, kg = F.tid >> 4;
    for (int unit = F.vcu; unit < DEPTH * 144; unit += F.G) {
        const int l = unit / 144, cb = unit % 144;
        const float* wp = w_mod + ((size_t)l * D + kg * 32) * (NMOD * D) + cb * 64 + ct * 4;
        f32x4 a0 = {0.f, 0.f, 0.f, 0.f}, a1 = a0, a2 = a0;
#pragma unroll 8
        for (int kk = 0; kk < 32; ++kk) { const f32x4 w = *(const f32x4*)(wp + (size_t)kk * (NMOD * D)); const int k = kg * 32 + kk;
            a0 += sil[k] * w; a1 += sil[D + k] * w; a2 += sil[2 * D + k] * w; }
        *(LAS f32x4*)(part + (kg * 3 + 0) * 64 + ct * 4) = a0; *(LAS f32x4*)(part + (kg * 3 + 1) * 64 + ct * 4) = a1; *(LAS f32x4*)(part + (kg * 3 + 2) * 64 + ct * 4) = a2;
        __syncthreads();
        if (F.tid < 192) { const int b = F.tid >> 6, col = F.tid & 63; float s = 0.f;
#pragma unroll 8
            for (int g = 0; g < 32; ++g) s += part[(g * 3 + b) * 64 + col];
            modp[((size_t)l * 3 + b) * (NMOD * D) + cb * 64 + col] = s + b_mod[(size_t)l * (NMOD * D) + cb * 64 + col]; }
        __syncthreads();
    }
    for (int e = F.vcu * (NWAVES * 64) + F.tid; e < SEQ_L * 32; e += F.G * NWAVES * 64) {
        const int t = e >> 5, ai = e & 31; const double pos = (ai < 16) ? (double)(t >> 6) : (double)(t & 63);
        double s, c; sincos_d(pos * ROPE_INV[ai & 15], s, c); ropec[e] = (float)c; ropes[e] = (float)s;
    }
}

__device__ __forceinline__ void transpose_item(const float* W, int K, int N, bf16* WT, int k0, int n0, int drow0, LAS float* scr, int lane) {
#pragma unroll 8
    for (int i = 0; i < 32; ++i) { const int kk = 2 * i + (lane >> 5); scr[kk * 33 + (lane & 31)] = W[(size_t)(k0 + kk) * N + n0 + (lane & 31)]; }
    LDS_WAIT(); asm volatile("" ::: "memory");
    const int c = lane & 7;
#pragma unroll
    for (int j = 0; j < 4; ++j) { const int n = (lane >> 3) + 8 * j; const LAS float* s = scr + (8 * c) * 33 + n;
        v4u o; o.x = pk2(s[0 * 33], s[1 * 33]); o.y = pk2(s[2 * 33], s[3 * 33]); o.z = pk2(s[4 * 33], s[5 * 33]); o.w = pk2(s[6 * 33], s[7 * 33]);
        *(GAS v4u*)(WT + (size_t)(drow0 + n) * K + k0 + 8 * c) = o; }
    LDS_WAIT(); asm volatile("" ::: "memory");
}
__device__ __forceinline__ int mod_row(int m) { return m < M_CTX ? 0 : 1 + ((m - M_CTX) >> 11); }
__device__ __forceinline__ void prenorm_row(Frame& F, const f32x4 (&v)[4], const float* w_pre, const float* shift, const float* scale, bf16* hrow) {
    float ss = 0.f;
#pragma unroll
    for (int j = 0; j < 4; ++j) ss += (v[j].x * v[j].x + v[j].y * v[j].y) + (v[j].z * v[j].z + v[j].w * v[j].w);
    const float rstd = 1.0f / sqrtf(wave_sum(ss) * (1.0f / D) + EPS);
    GAS unsigned long long* o8 = (GAS unsigned long long*)hrow + F.lane;
#pragma unroll
    for (int j = 0; j < 4; ++j) { const int col = 4 * F.lane + 256 * j; const f32x4 w = *(const f32x4*)(w_pre + col), sh = *(const f32x4*)(shift + col), sc = *(const f32x4*)(scale + col);
        const f32x4 h = (v[j] * rstd * w) * (1.0f + sc) + sh;
        o8[64 * j] = (unsigned long long)pk2(h.x, h.y) | ((unsigned long long)pk2(h.z, h.w) << 32); }
}
__device__ __forceinline__ void phase_pre(Frame& F) {
    frame_refresh(F);
    const float* ffn_w1 = inp<I_W1>(); const float* ffn_w2 = inp<I_W2>(); const float* w_in = inp<I_WIN>(); const float* w_out = inp<I_WOUT>();
    bf16* W1T = P_W1T(F); bf16* W2T = P_W2T(F); bf16* WINp = P_WIN(F); bf16* WOUTp = P_WOUT(F);
    LAS float* scr = (LAS float*)(F.lds + RING_OFF + F.wave * 16384);
    const int gw = F.vcu * NWAVES + F.wave, NGW = F.G * NWAVES;
    constexpr int I_W1 = 16 * 176, I_W2 = 44 * 32, I_IN = 16 * 48, I_OUT = 16 * 32, I_LAYER = 2 * I_W1 + 2 * I_W2 + I_IN + I_OUT;
    for (int it = gw; it < DEPTH * I_LAYER; it += NGW) {
        const int l = it / I_LAYER; int r = it % I_LAYER;
        if (r < 2 * I_W1) { const int f = r / I_W1; r %= I_W1; const int kb = r / 176, nb = r % 176, n0 = 32 * nb;
            const int nn = n0 < DFF ? n0 : n0 - DFF, drow0 = (nn >> 7) * 256 + (n0 < DFF ? 0 : 128) + (nn & 127);
            transpose_item(ffn_w1 + (size_t)(l * 2 + f) * D * (2 * DFF), D, 2 * DFF, W1T + (size_t)(l * 2 + f) * (2 * DFF) * D, 64 * kb, n0, drow0, scr, F.lane); continue; }
        r -= 2 * I_W1;
        if (r < 2 * I_W2) { const int f = r / I_W2; r %= I_W2; const int kb = r / 32, nb = r % 32;
            transpose_item(ffn_w2 + (size_t)(l * 2 + f) * DFF * D, DFF, D, W2T + (size_t)(l * 2 + f) * D * DFF, 64 * kb, 32 * nb, 32 * nb, scr, F.lane); continue; }
        r -= 2 * I_W2;
        if (r < I_IN) { const int kb = r / 48, nb = r % 48;
            transpose_item(w_in + (size_t)l * D * NIN, D, NIN, WINp + (size_t)l * NIN * D, 64 * kb, 32 * nb, 32 * nb, scr, F.lane); continue; }
        r -= I_IN;
        { const int kb = r / 32, nb = r % 32;
            transpose_item(w_out + (size_t)l * D * D, D, D, WOUTp + (size_t)l * D * D, 64 * kb, 32 * nb, 32 * nb, scr, F.lane); }
    }
    const float* x_prompt = inp<I_XP>(); const float* x_sample = inp<I_XS>(); const float* norm_w = inp<I_NORMW>(); const float* modp = P_MOD(F); bf16* Hp = P_H(F);
    for (int m = gw; m < M; m += NGW) {
        const float* xin = m < M_CTX ? x_prompt + (size_t)m * D : x_sample + (size_t)(m - M_CTX) * D;
        const GAS f32x4* xr = (const GAS f32x4*)xin + F.lane; GAS f32x4* xo = (GAS f32x4*)(F.out + (size_t)m * D) + F.lane;
        f32x4 v[4];
#pragma unroll
        for (int j = 0; j < 4; ++j) { v[j] = xr[64 * j]; xo[64 * j] = v[j]; }
        const float* md = modp + (size_t)mod_row(m) * (NMOD * D);
        prenorm_row(F, v, norm_w, md, md + D, Hp + (size_t)m * D);
    }
}

__device__ __forceinline__ void phase_norm(Frame& F, int l, int s) {
    frame_refresh(F);
    const float* norm_w = inp<I_NORMW>(); const float* modp = P_MOD(F); const float* Op = P_O(F); bf16* Hp = P_H(F);
    const int gw = F.vcu * NWAVES + F.wave, NGW = F.G * NWAVES;
    const int jpost = (s == 2) ? 1 : (s == 6) ? 3 : 5, jgate = (s == 2) ? 2 : (s == 6) ? 5 : 8;
    const float gs = (s == 6) ? 1.0f : 0.5f;
    const bool has_next = !(s == 9 && l == DEPTH - 1);
    const int ln = (s == 9) ? l + 1 : l, jpre = (s == 2) ? 2 : (s == 6) ? 4 : 0, jshift = (s == 2) ? 3 : (s == 6) ? 6 : 0;
    const float* w_post = norm_w + ((size_t)l * 6 + jpost) * D;
    for (int m = gw; m < M; m += NGW) {
        const int mr = mod_row(m);
        const float* gate = modp + ((size_t)(l * 3 + mr) * NMOD + jgate) * D;
        const GAS f32x4* orow = (const GAS f32x4*)(Op + (size_t)m * D) + F.lane; GAS f32x4* xrow = (GAS f32x4*)(F.out + (size_t)m * D) + F.lane;
        f32x4 o[4], v[4]; float ss = 0.f;
#pragma unroll
        for (int j = 0; j < 4; ++j) { o[j] = orow[64 * j]; v[j] = xrow[64 * j]; ss += (o[j].x * o[j].x + o[j].y * o[j].y) + (o[j].z * o[j].z + o[j].w * o[j].w); }
        const float rstd = 1.0f / sqrtf(wave_sum(ss) * (1.0f / D) + EPS);
#pragma unroll
        for (int j = 0; j < 4; ++j) { const int col = 4 * F.lane + 256 * j; const f32x4 w = *(const f32x4*)(w_post + col), g = *(const f32x4*)(gate + col);
            v[j] = v[j] + (gs * g) * (o[j] * rstd * w); xrow[64 * j] = v[j]; }
        if (has_next) {
            const float* mdn = modp + ((size_t)(ln * 3 + mr) * NMOD + jshift) * D;
            prenorm_row(F, v, norm_w + ((size_t)ln * 6 + jpre) * D, mdn, mdn + D, Hp + (size_t)m * D);
        }
    }
}

__device__ __forceinline__ void load8bf(const bf16* p, float (&f)[8]) {
    const v4u r = *(const v4u*)p;
    f[0] = __uint_as_float(r.x << 16); f[1] = __uint_as_float(r.x & 0xffff0000u); f[2] = __uint_as_float(r.y << 16); f[3] = __uint_as_float(r.y & 0xffff0000u);
    f[4] = __uint_as_float(r.z << 16); f[5] = __uint_as_float(r.z & 0xffff0000u); f[6] = __uint_as_float(r.w << 16); f[7] = __uint_as_float(r.w & 0xffff0000u);
}
__device__ __forceinline__ void mix_row_naive(Frame& F, int l, int m) {
    const int lane = F.lane;
    const float* cache_k = inp<I_CK>(); const float* cache_v = inp<I_CV>(); const float* attn_sink = inp<I_SINK>(); const float* w_spatial = inp<I_WSP>(); const float* b_spatial = inp<I_BSP>();
    const float* w_pool = inp<I_WPOOL>(); const float* pool_scale = inp<I_PSCALE>(); const float* ropec = P_ROPEC(F); const float* ropes = P_ROPES(F); const bf16* QKV = P_QKV(F); bf16* MIX = P_MIX(F);
    LAS float* qs = (LAS float*)(F.lds + F.wave * 4096); LAS float* sc = qs + 64;
    const bool lat = m >= M_CTX;
    int bl = 0, t, seq0, S;
    if (!lat) { t = m & 255; seq0 = m & ~255; S = SEQ_C; } else { const int r = m - M_CTX; bl = r >> 11; t = r & 2047; seq0 = M_CTX + (bl << 11); S = SEQ_L; }
    const bf16* qrow = QKV + (size_t)m * NIN;
    for (int hq = 0; hq < 8; ++hq) {
        const int kv = hq >> 2;
        float qv = bf2f(qrow[hq * 64 + lane]);
        if (lat) { const float pv = __shfl_xor(qv, 16); const int ai = (lane & 15) + ((lane >> 5) << 4); const float cs = ropec[t * 32 + ai], sn = ropes[t * 32 + ai];
            qv = (lane & 16) ? qv * cs + pv * sn : qv * cs - pv * sn; }
        qs[lane] = qv;
        LDS_WAIT(); asm volatile("" ::: "memory");
        int j0 = 0, nband = 0, nkeys = SEQ_C;
        if (lat) { j0 = t - 128 < 0 ? 0 : t - 128; const int j1 = t + 128 > SEQ_L - 1 ? SEQ_L - 1 : t + 128; nband = j1 - j0 + 1; nkeys = nband + PAST; }
        float mx = -3.0e38f;
        for (int idx = lane; idx < nkeys; idx += 64) {
            float dot = 0.f;
            if (!lat) {
                const bf16* kp = QKV + (size_t)(seq0 + idx) * NIN + 512 + kv * 64;
#pragma unroll
                for (int c8 = 0; c8 < 8; ++c8) { float kf[8]; load8bf(kp + 8 * c8, kf);
#pragma unroll
                    for (int e = 0; e < 8; ++e) dot += qs[8 * c8 + e] * kf[e]; }
            } else if (idx < nband) {
                const int kt = j0 + idx; const bf16* kp = QKV + (size_t)(seq0 + kt) * NIN + 512 + kv * 64;
                float kf[64];
#pragma unroll
                for (int c8 = 0; c8 < 8; ++c8) { float t8[8]; load8bf(kp + 8 * c8, t8);
#pragma unroll
                    for (int e = 0; e < 8; ++e) kf[8 * c8 + e] = t8[e]; }
#pragma unroll
                for (int a = 0; a < 2; ++a)
#pragma unroll
                    for (int d = 0; d < 16; ++d) { const float cs = ropec[kt * 32 + a * 16 + d], sn = ropes[kt * 32 + a * 16 + d]; const float z1 = kf[a * 32 + d], z2 = kf[a * 32 + 16 + d];
                        dot += qs[a * 32 + d] * (z1 * cs - z2 * sn) + qs[a * 32 + 16 + d] * (z2 * cs + z1 * sn); }
            } else {
                const float* kp = cache_k + ((((size_t)bl * DEPTH + l) * PAST + (idx - nband)) * 2 + kv) * 64;
#pragma unroll
                for (int c4 = 0; c4 < 16; ++c4) { const f32x4 k4 = *(const f32x4*)(kp + 4 * c4);
                    dot += qs[4 * c4] * k4.x + qs[4 * c4 + 1] * k4.y + qs[4 * c4 + 2] * k4.z + qs[4 * c4 + 3] * k4.w; }
            }
            const float sv = dot * 0.125f; sc[idx] = sv; mx = fmaxf(mx, sv);
        }
        const float sink = attn_sink[l * 8 + hq];
        mx = fmaxf(wave_max(mx), sink);
        float sum = 0.f;
        for (int idx = lane; idx < nkeys; idx += 64) { const float p = expf(sc[idx] - mx); sc[idx] = p; sum += p; }
        const float denom = wave_sum(sum) + expf(sink - mx);
        LDS_WAIT(); asm volatile("" ::: "memory");
        float acc = 0.f;
        for (int idx = 0; idx < nkeys; ++idx) {
            float vv;
            if (!lat || idx < nband) vv = bf2f(QKV[(size_t)(seq0 + j0 + idx) * NIN + 640 + kv * 64 + lane]);
            else vv = cache_v[((((size_t)bl * DEPTH + l) * PAST + (idx - nband)) * 2 + kv) * 64 + lane];
            acc += sc[idx] * vv;
        }
        MIX[(size_t)m * D + hq * 64 + lane] = (bf16)f2bf(acc / denom);
        LDS_WAIT(); asm volatile("" ::: "memory");
    }
    const int cb = m & ~127, p = m & 127;
    for (int h = 0; h < 4; ++h) {
        float r0, r1;
        { float ss0 = 0.f, ss1 = 0.f; const bf16* v0 = QKV + (size_t)(cb + lane) * NIN + 1024 + h * 64; const bf16* v1 = v0 + (size_t)64 * NIN;
#pragma unroll
            for (int c8 = 0; c8 < 8; ++c8) { float a[8], b[8]; load8bf(v0 + 8 * c8, a); load8bf(v1 + 8 * c8, b);
#pragma unroll
                for (int e = 0; e < 8; ++e) { ss0 += a[e] * a[e]; ss1 += b[e] * b[e]; } }
            r0 = 1.0f / sqrtf(ss0 * (1.0f / 64) + EPS); r1 = 1.0f / sqrtf(ss1 * (1.0f / 64) + EPS); }
        const float* wrow = w_spatial + (((size_t)l * 4 + h) * 128 + p) * 128;
        float z = 0.f;
        for (int q = 0; q < 128; ++q) { const float rq = __shfl(q < 64 ? r0 : r1, q & 63);
            z += wrow[q] * (rq * bf2f(QKV[(size_t)(cb + q) * NIN + 1024 + h * 64 + lane])); }
        z += b_spatial[((size_t)l * 4 + h) * 128 + p];
        const float gu = bf2f(qrow[768 + h * 64 + lane]);
        MIX[(size_t)m * D + 512 + h * 64 + lane] = (bf16)f2bf(gu * z);
    }
    for (int g = 0; g < 4; ++g) {
        const int w = 2 << g; const int lo = t - w / 2 < 0 ? 0 : t - w / 2, hi = t + w / 2 > S ? S : t + w / 2;
        float sum = 0.f;
        for (int tt = lo; tt < hi; ++tt) sum += bf2f(QKV[(size_t)(seq0 + tt) * NIN + 1280 + g * 64 + lane]);
        const float dv = sum / (float)(hi - lo) - bf2f(qrow[1280 + g * 64 + lane]);
        const float* wp = w_pool + ((size_t)l * 4 + g) * 64 * 64;
        float o = 0.f;
        for (int i = 0; i < 64; ++i) o += __shfl(dv, i) * wp[i * 64 + lane];
        MIX[(size_t)m * D + 768 + g * 64 + lane] = (bf16)f2bf(o * pool_scale[l * 256 + g * 64 + lane]);
    }
    if (!lat) { const int b = m >> 8; float* ok = F.out + (size_t)M * D + (((size_t)b * DEPTH + l) * SEQ_C + t) * 128; float* ov = ok + (size_t)32 * DEPTH * SEQ_C * 128;
        ok[lane] = bf2f(qrow[512 + lane]); ok[64 + lane] = bf2f(qrow[576 + lane]); ov[lane] = bf2f(qrow[640 + lane]); ov[64 + lane] = bf2f(qrow[704 + lane]); }
}
__device__ __forceinline__ void phase_mix(Frame& F, int l) {
    frame_refresh(F);
    const int gw = F.vcu * NWAVES + F.wave, NGW = F.G * NWAVES;
    for (int m = gw; m < M; m += NGW) mix_row_naive(F, l, m);
}

struct Args { const float* in[18]; float* out; unsigned char* ws; int ph_lo, ph_hi, li, pad; };
__global__ void __launch_bounds__(NWAVES * 64, 2) mk_fwd(Args args) {
    extern __shared__ __attribute__((aligned(16))) unsigned char lds[];
    Frame F;
    F.lds = (LAS unsigned char*)lds;
    F.tid = threadIdx.x; F.lane = F.tid & 63; F.wave = __builtin_amdgcn_readfirstlane(F.tid >> 6);
    F.G = gridDim.x; { const int bx = blockIdx.x; F.vcu = (F.G % 8 == 0) ? (bx % 8) * (F.G / 8) + bx / 8 : bx; }
    unsigned char* ws = args.ws;
    F.ws = ws; F.out = args.out;
    volatile LAS unsigned* MISC = (volatile LAS unsigned*)(F.lds + MISC_OFF);
    for (int u = F.tid; u < (LDS_BYTES - LDSCTL_OFF) / 4; u += NWAVES * 64) ((LAS unsigned*)(F.lds + LDSCTL_OFF))[u] = 0u;
    __syncthreads();
    XcdBarrier bar; bar.bar = (unsigned*)(ws + WS_CTL) + CW_BAR; bar.x = 0; bar.st = nullptr;
    if (N_LAUNCHES == 1) bar = xcd_barrier_post((unsigned*)(ws + WS_CTL) + CW_BAR, MISC + 8);

    for (int ph = args.ph_lo; ph < args.ph_hi; ++ph) {
        if (ph == 0) phase_mod(F);
        if (ph == 1) phase_pre(F);
        if (ph >= 2) {
            const int q = ph - 2, l = q / 10, s = q % 10;
            if (s == 0 || s == 7) {
                const int f = (s == 7) ? 1 : 0;
                pg8::Gemm g{P_H(F), P_W1T(F) + (size_t)(l * 2 + f) * (2 * DFF) * D, M, 2 * DFF, D}; pg8::StaticOrder S; S.init(M, 2 * DFF, F.G, (int)blockIdx.x);
                pg8::EpiSwiglu E{P_A(F), DFF};
                pg8::gemm_phase<pg8::EpiSwiglu, pg8::StaticOrder, true, true>(F.lds + RING_OFF, g, S, E);
            } else if (s == 1 || s == 8 || s == 5) {
                const int f = (s == 8) ? 1 : 0;
                pg8::Gemm g{P_A(F), P_W2T(F) + (size_t)(l * 2 + f) * D * DFF, M, D, DFF};
                if (s == 5) { g.A = P_MIX(F); g.Bt = P_WOUT(F) + (size_t)l * D * D; g.K = D; }
                pg8::StaticOrder S; S.init(M, D, F.G, (int)blockIdx.x);
                pg8::EpiF32 E{P_O(F), D};
                pg8::gemm_phase<pg8::EpiF32, pg8::StaticOrder, true, true>(F.lds + RING_OFF, g, S, E);
            } else if (s == 3) {
                pg8::Gemm g{P_H(F), P_WIN(F) + (size_t)l * NIN * D, M, NIN, D}; pg8::StaticOrder S; S.init(M, NIN, F.G, (int)blockIdx.x);
                pg8::EpiBf16P E{P_QKV(F), NIN};
                pg8::gemm_phase<pg8::EpiBf16P, pg8::StaticOrder, true, true>(F.lds + RING_OFF, g, S, E);
            } else if (s == 4) {
                phase_mix(F, l);
            } else {
                phase_norm(F, l, s);
            }
        }
        if (ph + 1 < args.ph_hi) xcd_barrier(bar);
    }
}

extern "C" void kernel_launch(void* const* d_in, const int* in_sizes, int n_in, void* d_out, int out_size, void* d_ws, size_t ws_size, hipStream_t stream) {
    static int grid = 0;
    if (grid == 0) {
        if (n_in != 18 || ws_size < WS_END) { fprintf(stderr, "kernel_launch: built for 18 inputs and >= %zu bytes of workspace; got n_in %d, ws %zu; nothing launched\n", (size_t)WS_END, n_in, ws_size); grid = -1; return; }
        int dev = 0, cus = 0, per_cu = 0;
        if (hipGetDevice(&dev) != hipSuccess || hipDeviceGetAttribute(&cus, hipDeviceAttributeMultiprocessorCount, dev) != hipSuccess) { fprintf(stderr, "kernel_launch: hipGetDevice / hipDeviceGetAttribute failed\n"); grid = -1; return; }
        if (hipFuncSetAttribute((const void*)mk_fwd, hipFuncAttributeMaxDynamicSharedMemorySize, LDS_BYTES) != hipSuccess) { fprintf(stderr, "kernel_launch: hipFuncSetAttribute failed\n"); grid = -1; return; }
        if (hipOccupancyMaxActiveBlocksPerMultiprocessor(&per_cu, (const void*)mk_fwd, NWAVES * 64, LDS_BYTES) != hipSuccess || per_cu < 1)
            fprintf(stderr, "kernel_launch: note: the occupancy query reports %d workgroups per CU\n", per_cu);
        (void)hipGetLastError();
        grid = cus;
    }
    if (grid < 0) return;
    if (hipMemsetAsync((char*)d_ws + WS_CTL, 0, CTL_ZERO_BYTES, stream) != hipSuccess) { fprintf(stderr, "kernel_launch: hipMemsetAsync failed\n"); return; }
    Args a{};
    for (int i = 0; i < 18; ++i) a.in[i] = (const float*)d_in[i];
    a.out = (float*)d_out; a.ws = (unsigned char*)d_ws;
    for (int li = 0; li < N_LAUNCHES; ++li) {
        a.ph_lo = (N_LAUNCHES == 1) ? 0 : li; a.ph_hi = (N_LAUNCHES == 1) ? NPHASE : li + 1; a.li = li;
        hipLaunchKernelGGL(mk_fwd, dim3(grid), dim3(NWAVES * 64), LDS_BYTES, stream, a);
        const hipError_t le = hipPeekAtLastError();
        if (le != hipSuccess) { fprintf(stderr, "kernel_launch: launch %d failed: %s\n", li, hipGetErrorName(le)); break; }
    }
}
```

```cpp
#include <hip/hip_runtime.h>
#include <cstdio>
#include <cstdint>
namespace pg8 {
#define PG8_LAS __attribute__((address_space(3)))
typedef unsigned short bf16_t;
typedef short bf16x8 __attribute__((ext_vector_type(8)));
typedef float f32x4 __attribute__((ext_vector_type(4)));
typedef unsigned u32x4 __attribute__((ext_vector_type(4)));
constexpr int BM = 256, BK = 64, HALF = 128, HTB = HALF * BK * 2  , STAGE_BYTES = 8 * HTB, NXCD = 8, WGM = 8;

__host__ __device__ __forceinline__ int lds_byte(int r, int c) { const int st = (r >> 4) * 2 + (c >> 5), rr = r & 15, cc = c & 31, ob = rr * 64 + cc * 2; return st * 1024 + (ob ^ (((ob >> 9) & 1) << 5)); }
__host__ __device__ __forceinline__ void stage_rc(int b, int& R, int& C) { const int st = b / 1024, sb = b % 1024, swz = sb ^ (((sb >> 9) & 1) << 5); R = (st >> 1) * 16 + swz / 64; C = (st & 1) * 32 + (swz % 64) / 2; }
__host__ __device__ __forceinline__ int perm32(int rho) { const int n = rho >> 4, i = rho & 15; return 8 * (i >> 2) + 4 * n + (i & 3); }

struct Unit { int pm, pn; };
struct Gemm { const bf16_t* A; const bf16_t* Bt; int M, N, K; };

struct StaticOrder {
    int nM, nN, nwg, G, c;
    __host__ __device__ void init(int M, int N, int G_, int c_) { nM = M / BM; nN = N / BM; nwg = nM * nN; G = G_; c = c_; }
    __host__ __device__ bool next(int i, Unit& u) const {
        const long L = (long)i * G + c; if (L >= nwg) return false;
        int wgid = (int)L; { const int q = nwg / NXCD, r = nwg % NXCD, xcd = wgid % NXCD, off = wgid / NXCD; wgid = (xcd < r ? xcd * (q + 1) : r * (q + 1) + (xcd - r) * q) + off; }
        const int nig = WGM * nN, gid = wgid / nig, fm = gid * WGM, gsz = (nM - fm) < WGM ? (nM - fm) : WGM;
        u.pm = fm + ((wgid % nig) % gsz); u.pn = (wgid % nig) / gsz; return true;
    }
    __device__ __forceinline__ void a_ready(const Unit&) const {}
    __device__ __forceinline__ void done(const Unit&) const {}
};

__device__ __forceinline__ unsigned cvt_pk_bf16(float lo, float hi) { unsigned r; asm volatile("v_cvt_pk_bf16_f32 %0, %1, %2" : "=v"(r) : "v"(lo), "v"(hi)); return r; }
struct EpiF32 {
    static constexpr bool PERM = false, AFTER_DRAIN = false;
    float* C; int ldc;
    __device__ __forceinline__ void operator()(const f32x4 (&acc)[2][2][4][2], const Unit& u, int wr, int wc, int fr, int fq) const {
        const int row0 = u.pm * BM + wr * 64 + fr, col0 = u.pn * BM + wc * 32 + 4 * fq;
#pragma unroll
        for (int ai = 0; ai < 2; ++ai)
#pragma unroll
            for (int m = 0; m < 4; ++m) { float* rowp = C + (size_t)(row0 + ai * HALF + m * 16) * ldc + col0;
#pragma unroll
                for (int bj = 0; bj < 2; ++bj)
#pragma unroll
                    for (int n = 0; n < 2; ++n) *(f32x4*)(rowp + bj * HALF + n * 16) = acc[ai][bj][m][n]; }
    }
};
struct EpiBf16P {
    static constexpr bool PERM = true, AFTER_DRAIN = false;
    bf16_t* O; int ldc;
    __device__ __forceinline__ void operator()(const f32x4 (&acc)[2][2][4][2], const Unit& u, int wr, int wc, int fr, int fq) const {
        const int row0 = u.pm * BM + wr * 64 + fr, col0 = u.pn * BM + wc * 32 + 8 * fq;
#pragma unroll
        for (int ai = 0; ai < 2; ++ai)
#pragma unroll
            for (int m = 0; m < 4; ++m) { bf16_t* rowp = O + (size_t)(row0 + ai * HALF + m * 16) * ldc + col0;
#pragma unroll
                for (int bj = 0; bj < 2; ++bj) { const f32x4 v0 = acc[ai][bj][m][0], v1 = acc[ai][bj][m][1];
                    u32x4 w; w.x = cvt_pk_bf16(v0[0], v0[1]); w.y = cvt_pk_bf16(v0[2], v0[3]); w.z = cvt_pk_bf16(v1[0], v1[1]); w.w = cvt_pk_bf16(v1[2], v1[3]);
                    *(u32x4*)(rowp + bj * HALF) = w; } }
    }
};
__device__ __forceinline__ float silu_mul(float g, float u) { return g * __builtin_amdgcn_rcpf(1.0f + __builtin_amdgcn_exp2f(-1.4426950408889634f * g)) * u; }
struct EpiSwiglu {
    static constexpr bool PERM = true, AFTER_DRAIN = false;
    bf16_t* O; int ldc;
    __device__ __forceinline__ void operator()(const f32x4 (&acc)[2][2][4][2], const Unit& u, int wr, int wc, int fr, int fq) const {
        const int row0 = u.pm * BM + wr * 64 + fr, col0 = u.pn * HALF + wc * 32 + 8 * fq;
#pragma unroll
        for (int ai = 0; ai < 2; ++ai)
#pragma unroll
            for (int m = 0; m < 4; ++m) { bf16_t* rowp = O + (size_t)(row0 + ai * HALF + m * 16) * ldc + col0;
                const f32x4 g0 = acc[ai][0][m][0], g1 = acc[ai][0][m][1], u0 = acc[ai][1][m][0], u1 = acc[ai][1][m][1];
                u32x4 w; w.x = cvt_pk_bf16(silu_mul(g0[0], u0[0]), silu_mul(g0[1], u0[1])); w.y = cvt_pk_bf16(silu_mul(g0[2], u0[2]), silu_mul(g0[3], u0[3]));
                w.z = cvt_pk_bf16(silu_mul(g1[0], u1[0]), silu_mul(g1[1], u1[1])); w.w = cvt_pk_bf16(silu_mul(g1[2], u1[2]), silu_mul(g1[3], u1[3]));
                *(u32x4*)rowp = w; }
    }
};

template <class Epi, class Sched, bool ALIGN_EPI = false, bool SP2 = false>
__device__ __forceinline__ void gemm_phase(PG8_LAS unsigned char* lds, const Gemm g, const Sched& S, const Epi& E) {
    int tid_ = threadIdx.x; asm volatile("" : "+v"(tid_));
    const int tid = tid_, wid = __builtin_amdgcn_readfirstlane(tid >> 6), lane = tid & 63, wr = wid >> 2, wc = wid & 3, fr = lane & 15, fq = lane >> 4;
    const int K = g.K, nt = K / BK;
    unsigned voffA[2], voffB[2];
#pragma unroll
    for (int i = 0; i < 2; ++i) { int R, C; stage_rc(tid * 16 + i * 8192, R, C); const int Rb = Epi::PERM ? ((R & ~31) + perm32(R & 31)) : R;
        voffA[i] = (unsigned)(R * K + C) * 2u; voffB[i] = (unsigned)(Rb * K + C) * 2u; }
    const size_t kstep = (size_t)(BK * 2);
    const size_t hstep = (size_t)HALF * K * 2;
    const size_t tstep = 2 * hstep;
    const unsigned ldsw = (unsigned)wid * 1024u;
    const int aoff = lds_byte(wr * 64 + fr, fq * 8), boff = lds_byte(wc * 32 + fr, fq * 8);
#define PG8_SA(b, h) (((b) * 2 + (h)) * HTB)
#define PG8_SB(b, h) ((4 + (b) * 2 + (h)) * HTB)
#define PG8_STAGE(bufoff, gbase, voff) do { _Pragma("unroll") for (int _i = 0; _i < 2; ++_i) \
        __builtin_amdgcn_global_load_lds((const unsigned*)((const char*)(gbase) + (voff)[_i]), (PG8_LAS unsigned*)(lds + (bufoff) + ldsw + _i * 8192), 16, 0, 0); } while (0)
#define PG8_LDA(dst, b, h) do { _Pragma("unroll") for (int m = 0; m < 4; ++m) _Pragma("unroll") for (int k = 0; k < 2; ++k) dst[m][k] = *(const PG8_LAS bf16x8*)(lds + PG8_SA(b, h) + aoff + m * 2048 + k * 1024); } while (0)
#define PG8_LDB(dst, b, h) do { _Pragma("unroll") for (int n = 0; n < 2; ++n) _Pragma("unroll") for (int k = 0; k < 2; ++k) dst[n][k] = *(const PG8_LAS bf16x8*)(lds + PG8_SB(b, h) + boff + n * 2048 + k * 1024); } while (0)
#define PG8_MMA(ai, bj, At, Bt) do { __builtin_amdgcn_s_setprio(1); _Pragma("unroll") for (int m = 0; m < 4; ++m) _Pragma("unroll") for (int n = 0; n < 2; ++n) _Pragma("unroll") for (int k = 0; k < 2; ++k) \
        acc[ai][bj][m][n] = __builtin_amdgcn_mfma_f32_16x16x32_bf16(Bt[n][k], At[m][k], acc[ai][bj][m][n], 0, 0, 0); __builtin_amdgcn_s_setprio(0); } while (0)
#define PG8_WAIT_V(n) asm volatile("s_waitcnt vmcnt(" #n ")" ::: "memory")
#define PG8_WAIT_L(n) asm volatile("s_waitcnt lgkmcnt(" #n ")" ::: "memory")
#define PG8_BAR __builtin_amdgcn_s_barrier()
#define PG8_SCHED __builtin_amdgcn_sched_barrier(0)
    Unit cur, nxt; int ui = 0;
    if (!S.next(0, cur)) return;
    f32x4 acc[2][2][4][2];
#pragma unroll
    for (int a = 0; a < 2; ++a)
#pragma unroll
        for (int b = 0; b < 2; ++b)
#pragma unroll
            for (int m = 0; m < 4; ++m)
#pragma unroll
                for (int n = 0; n < 2; ++n) acc[a][b][m][n] = (f32x4){0.f, 0.f, 0.f, 0.f};
    bf16x8 At[4][2], B0[2][2], B1[2][2];
    const char* cA = (const char*)g.A + (size_t)cur.pm * tstep; const char* cB = (const char*)g.Bt + (size_t)cur.pn * tstep;
    S.a_ready(cur);
    if constexpr (SP2) {
        PG8_STAGE(PG8_SB(0, 0), cB, voffB); PG8_STAGE(PG8_SB(0, 1), cB + hstep, voffB); PG8_STAGE(PG8_SA(0, 0), cA, voffA); PG8_STAGE(PG8_SA(0, 1), cA + hstep, voffA);
        if (wr == 1) PG8_BAR;
        PG8_WAIT_V(2); PG8_BAR;
        PG8_STAGE(PG8_SB(1, 0), cB + kstep, voffB); PG8_STAGE(PG8_SA(1, 0), cA + kstep, voffA); PG8_STAGE(PG8_SB(1, 1), cB + hstep + kstep, voffB);
        PG8_WAIT_V(6); PG8_BAR;
    } else {
        PG8_STAGE(PG8_SB(0, 0), cB, voffB); PG8_STAGE(PG8_SA(0, 0), cA, voffA); PG8_STAGE(PG8_SB(0, 1), cB + hstep, voffB); PG8_STAGE(PG8_SA(0, 1), cA + hstep, voffA);
        if (wr == 1) PG8_BAR;
        PG8_WAIT_V(4); PG8_BAR;
        PG8_STAGE(PG8_SB(1, 0), cB + kstep, voffB); PG8_STAGE(PG8_SA(1, 0), cA + kstep, voffA); PG8_STAGE(PG8_SB(1, 1), cB + hstep + kstep, voffB);
        PG8_WAIT_V(6); PG8_BAR;
    }
    for (;;) {
        const bool has_next = S.next(ui + 1, nxt);
        const char* nA = has_next ? (const char*)g.A + (size_t)nxt.pm * tstep : cA; const char* nB = has_next ? (const char*)g.Bt + (size_t)nxt.pn * tstep : cB;
        for (int t = 0; t < nt; t += 2) {
            const bool last = (t == nt - 2);
            const char* a1 = cA + (size_t)(t + 1) * kstep;
            const char* a2 = last ? nA : cA + (size_t)(t + 2) * kstep; const char* b2 = last ? nB : cB + (size_t)(t + 2) * kstep;
            const char* a3 = a2 + kstep; const char* b3 = b2 + kstep;
            if (last && has_next) S.a_ready(nxt);
            if constexpr (SP2) {
            PG8_LDB(B0, 0, 0); PG8_LDB(B1, 0, 1); PG8_SCHED; PG8_LDA(At, 0, 0); PG8_STAGE(PG8_SA(1, 1), a1 + hstep, voffA);
            PG8_WAIT_V(8); PG8_WAIT_L(0); PG8_BAR; PG8_MMA(0, 0, At, B0); PG8_MMA(0, 1, At, B1); PG8_BAR; PG8_SCHED;
            PG8_LDA(At, 0, 1); PG8_STAGE(PG8_SB(0, 0), b2, voffB); PG8_STAGE(PG8_SB(0, 1), b2 + hstep, voffB); PG8_STAGE(PG8_SA(0, 0), a2, voffA);
            PG8_WAIT_V(8); PG8_WAIT_L(0); PG8_BAR; PG8_MMA(1, 0, At, B0); PG8_MMA(1, 1, At, B1); PG8_BAR; PG8_SCHED;
            PG8_LDB(B0, 1, 0); PG8_LDB(B1, 1, 1); PG8_SCHED; PG8_LDA(At, 1, 0); PG8_STAGE(PG8_SA(0, 1), a2 + hstep, voffA);
            PG8_WAIT_V(8); PG8_WAIT_L(0); PG8_BAR; PG8_MMA(0, 0, At, B0); PG8_MMA(0, 1, At, B1); PG8_BAR; PG8_SCHED;
            PG8_LDA(At, 1, 1); PG8_STAGE(PG8_SB(1, 0), b3, voffB); PG8_STAGE(PG8_SB(1, 1), b3 + hstep, voffB); PG8_STAGE(PG8_SA(1, 0), a3, voffA);
            PG8_WAIT_V(8); PG8_WAIT_L(0); PG8_BAR; PG8_MMA(1, 0, At, B0); PG8_MMA(1, 1, At, B1); PG8_BAR; PG8_SCHED;
            } else {
            PG8_LDB(B0, 0, 0); PG8_SCHED; PG8_LDA(At, 0, 0); PG8_STAGE(PG8_SA(1, 1), a1 + hstep, voffA);
            PG8_WAIT_L(8); PG8_BAR; PG8_WAIT_L(0); PG8_MMA(0, 0, At, B0); PG8_BAR; PG8_SCHED;
            PG8_LDB(B1, 0, 1); PG8_STAGE(PG8_SB(0, 0), b2, voffB);
            PG8_BAR; PG8_WAIT_L(0); PG8_MMA(0, 1, At, B1); PG8_BAR;
            PG8_LDA(At, 0, 1); PG8_STAGE(PG8_SA(0, 0), a2, voffA);
            PG8_BAR; PG8_WAIT_L(0); PG8_MMA(1, 0, At, B0); PG8_BAR; PG8_SCHED;
            PG8_STAGE(PG8_SB(0, 1), b2 + hstep, voffB);
            PG8_WAIT_V(6); PG8_BAR; PG8_MMA(1, 1, At, B1); PG8_BAR;
            PG8_LDB(B0, 1, 0); PG8_SCHED; PG8_LDA(At, 1, 0); PG8_STAGE(PG8_SA(0, 1), a2 + hstep, voffA);
            PG8_WAIT_L(8); PG8_BAR; PG8_WAIT_L(0); PG8_MMA(0, 0, At, B0); PG8_BAR; PG8_SCHED;
            PG8_LDB(B1, 1, 1); PG8_STAGE(PG8_SB(1, 0), b3, voffB);
            PG8_BAR; PG8_WAIT_L(0); PG8_MMA(0, 1, At, B1); PG8_BAR;
            PG8_LDA(At, 1, 1); PG8_STAGE(PG8_SA(1, 0), a3, voffA);
            PG8_BAR; PG8_WAIT_L(0); PG8_MMA(1, 0, At, B0); PG8_BAR; PG8_SCHED;
            PG8_STAGE(PG8_SB(1, 1), b3 + hstep, voffB);
            PG8_WAIT_V(6); PG8_BAR; PG8_MMA(1, 1, At, B1); PG8_BAR;
            }
        }
        if constexpr (ALIGN_EPI) { if (wr == 0) PG8_BAR; }
        if constexpr (!Epi::AFTER_DRAIN) { E(acc, cur, wr, wc, fr, fq); S.done(cur); }
        if (!has_next) break;
#pragma unroll
        for (int a = 0; a < 2; ++a)
#pragma unroll
            for (int b = 0; b < 2; ++b)
#pragma unroll
                for (int m = 0; m < 4; ++m)
#pragma unroll
                    for (int n = 0; n < 2; ++n) acc[a][b][m][n] = (f32x4){0.f, 0.f, 0.f, 0.f};
        cur = nxt; cA = nA; cB = nB; ++ui;
        if constexpr (ALIGN_EPI) { if (wr == 1) PG8_BAR; }
    }
    PG8_WAIT_V(0);
    if constexpr (!ALIGN_EPI) { if (wr == 0) PG8_BAR; }
    PG8_BAR;
    if constexpr (Epi::AFTER_DRAIN) { E.fused(acc, cur, wr, wc, fr, fq, lds, wid, lane); S.done(cur); }
#undef PG8_SA
#undef PG8_SB
#undef PG8_STAGE
#undef PG8_LDA
#undef PG8_LDB
#undef PG8_MMA
#undef PG8_WAIT_V
#undef PG8_WAIT_L
#undef PG8_BAR
#undef PG8_SCHED
}
}

#define GAS __attribute__((address_space(1)))
#define LAS __attribute__((address_space(3)))
typedef unsigned short bf16;
typedef unsigned v4u __attribute__((ext_vector_type(4)));
typedef float f32x4 __attribute__((ext_vector_type(4)));
typedef short bf16x8 __attribute__((ext_vector_type(8)));
typedef GAS unsigned gu32;
typedef GAS unsigned long long gu64;
#define RLX_AGENT __ATOMIC_RELAXED, __HIP_MEMORY_SCOPE_AGENT
#define LDS_WAIT() asm volatile("s_waitcnt lgkmcnt(0)" ::: "memory")
#define VM_WAIT() asm volatile("s_waitcnt vmcnt(0)" ::: "memory")
__device__ __forceinline__ unsigned long long rt() { return __builtin_amdgcn_s_memrealtime(); }
__device__ __forceinline__ unsigned f2bf(float f) { unsigned u = __builtin_bit_cast(unsigned, f); return (u + 0x7fffu + ((u >> 16) & 1u)) >> 16; }
__device__ __forceinline__ unsigned pk2(float lo, float hi) { return f2bf(lo) | (f2bf(hi) << 16); }

#define XB_TMO      128
#define XB_XCNT(j)  (256  + 64 * (j))
#define XB_XSUB(j)  (1280 + 64 * (j))
#define XB_XGEN(j)  (2304 + 64 * (j))
#define XB_TOP      3328
#define XB_TOPGEN   3392
#define XCD_BAR_WORDS 3456
#define XB_SPIN_CAP (1u << 18)

__device__ __forceinline__ unsigned xb_ld(unsigned* p)              { return __hip_atomic_load(p, __ATOMIC_RELAXED, __HIP_MEMORY_SCOPE_AGENT); }
__device__ __forceinline__ unsigned xb_add(unsigned* p, unsigned v) { return __hip_atomic_fetch_add(p, v, __ATOMIC_RELAXED, __HIP_MEMORY_SCOPE_AGENT); }
__device__ __forceinline__ unsigned xb_xcc_id() { return (unsigned)__builtin_amdgcn_s_getreg((3 << 11) | 20) & 0xFu; }
#define XB_SPIN(cond, bar) do { unsigned _sp = 0; while (cond) { __builtin_amdgcn_s_sleep(1); \
    if ((++_sp & 255u) == 0u) { if (xb_ld(&(bar)[XB_TMO])) break; if (_sp > XB_SPIN_CAP) { atomicAdd(&(bar)[XB_TMO], 1u); break; } } } } while (0)

struct XcdBarrier {
    unsigned* bar; unsigned x;
    volatile LAS unsigned* st;
};

__device__ __forceinline__ XcdBarrier xcd_barrier_post(unsigned* bar, volatile LAS unsigned* st) {
    XcdBarrier b; b.bar = bar; b.x = xb_xcc_id(); b.st = st;
    if (threadIdx.x == 0) (void)xb_add(&bar[XB_XCNT(b.x)], 1u);
    return b;
}
__device__ __forceinline__ void xcd_barrier_complete(unsigned* bar, unsigned x, unsigned& nloc, unsigned& nx) {
    const unsigned G = gridDim.x * gridDim.y * gridDim.z;
    unsigned sum, cnt, mine, sp = 0u;
    for (;;) {
        sum = 0u; cnt = 0u; mine = 0u;
#pragma unroll
        for (unsigned j = 0; j < 16; ++j) { const unsigned c = xb_ld(&bar[XB_XCNT(j)]); sum += c; cnt += (c > 0u) ? 1u : 0u; mine = (j == x) ? c : mine; }
        if (sum == G) break;
        __builtin_amdgcn_s_sleep(1);
        if ((++sp & 255u) == 0u) { if (xb_ld(&bar[XB_TMO])) break; if (sp > XB_SPIN_CAP) { atomicAdd(&bar[XB_TMO], 1u); break; } }
    }
    nloc = mine > 0u ? mine : 1u; nx = cnt > 0u ? cnt : 1u;
}

__device__ __forceinline__ void xcd_barrier(const XcdBarrier& b) {
    asm volatile("s_waitcnt vmcnt(0)" ::: "memory");
    __syncthreads();
    if (threadIdx.x == 0) {
        unsigned* bar = b.bar;
        __builtin_amdgcn_s_waitcnt(0);
        unsigned nloc = b.st[0], nx = b.st[1];
        if (nloc == 0u) { xcd_barrier_complete(bar, b.x, nloc, nx); b.st[0] = nloc; b.st[1] = nx; }
        const unsigned old = xb_add(&bar[XB_XSUB(b.x)], 1u);
        const unsigned gen = old / nloc;
        if (old + 1u == (gen + 1u) * nloc) {
            __builtin_amdgcn_fence(__ATOMIC_RELEASE, "agent");
            asm volatile("s_waitcnt vmcnt(0)" ::: "memory");
            const unsigned og = xb_add(&bar[XB_TOP], 1u);
            const unsigned tg = og / nx;
            if (og + 1u == (tg + 1u) * nx) xb_add(&bar[XB_TOPGEN], 1u);
            else XB_SPIN(xb_ld(&bar[XB_TOPGEN]) == tg, bar);
            __builtin_amdgcn_fence(__ATOMIC_ACQUIRE, "agent");
            xb_add(&bar[XB_XGEN(b.x)], 1u);
            asm volatile("s_waitcnt vmcnt(0)" ::: "memory");
        } else {
            XB_SPIN(xb_ld(&bar[XB_XGEN(b.x)]) == gen, bar);
            __builtin_amdgcn_fence(__ATOMIC_ACQUIRE, "agent");
            asm volatile("s_waitcnt vmcnt(0)" ::: "memory");
        }
    }
    __syncthreads();
}

constexpr int NWAVES = 8;
#ifndef MK_N_LAUNCHES
#define MK_N_LAUNCHES 1
#endif
#ifndef MK_NAIVE_MIX
#define MK_NAIVE_MIX 0
#endif

constexpr int D = 1024, DEPTH = 4, DFF = 2816, NIN = 1536, NMOD = 9;
constexpr int M_CTX = 32 * 256, M_LAT = 2 * 2048, M = M_CTX + M_LAT;
constexpr int SEQ_C = 256, SEQ_L = 2048, PAST = 512;
constexpr float EPS = 1e-6f;
constexpr int NPHASE = 2 + 10 * DEPTH;
constexpr int N_LAUNCHES = (MK_N_LAUNCHES == 1) ? 1 : NPHASE;

constexpr size_t MiB = 1u << 20;
constexpr size_t WS_CTL = 0, CTL_ZERO_BYTES = 1 * MiB;
constexpr size_t WS_MOD = 1 * MiB;
constexpr size_t WS_ROPE = 2 * MiB;
constexpr size_t WS_W1T = 4 * MiB;
constexpr size_t WS_W2T = 92 * MiB;
constexpr size_t WS_WIN = 136 * MiB;
constexpr size_t WS_WOUT = 148 * MiB;
constexpr size_t WS_H = 156 * MiB;
constexpr size_t WS_A = 180 * MiB;
constexpr size_t WS_O = 246 * MiB;
constexpr size_t WS_QKV = 294 * MiB;
constexpr size_t WS_MIX = 330 * MiB;
constexpr size_t WS_END = 354 * MiB;
constexpr int CW_BAR = 4096;

constexpr int RING_OFF = 0, RING_BYTES = 131072;
constexpr int LDSCTL_OFF = RING_BYTES, MISC_OFF = LDSCTL_OFF + 320;
constexpr int LDS_BYTES = 147456;

__device__ __forceinline__ float bf2f(unsigned short v) { return __uint_as_float((unsigned)v << 16); }
__device__ __forceinline__ float wave_sum(float v) {
#pragma unroll
    for (int o = 1; o < 64; o <<= 1) v += __shfl_xor(v, o);
    return v;
}
__device__ __forceinline__ float wave_max(float v) {
#pragma unroll
    for (int o = 1; o < 64; o <<= 1) v = fmaxf(v, __shfl_xor(v, o));
    return v;
}

struct Frame {
    LAS unsigned char* lds;
    int tid, lane, wave, vcu, G;
    unsigned char* ws; float* out;
};
__device__ __forceinline__ void frame_refresh(Frame& F) {
    int t_ = threadIdx.x, b_ = blockIdx.x; asm volatile("" : "+v"(t_)); asm volatile("" : "+s"(b_));
    F.tid = t_; F.lane = t_ & 63; F.wave = __builtin_amdgcn_readfirstlane(t_ >> 6);
    F.G = gridDim.x; F.vcu = (F.G % 8 == 0) ? (b_ % 8) * (F.G / 8) + b_ / 8 : b_;
}
typedef __attribute__((address_space(4))) const unsigned char* kargp_t;
template <int I> __device__ __forceinline__ const float* inp() {
    kargp_t kp = (kargp_t)__builtin_amdgcn_kernarg_segment_ptr(); unsigned long long v;
    asm volatile("s_load_dwordx2 %0, %1, %2\n\ts_waitcnt lgkmcnt(0)" : "=s"(v) : "s"(kp), "i"(8 * I) : "memory");
    return (const float*)v;
}
enum { I_XP = 0, I_XS, I_CK, I_CV, I_C, I_CCTX, I_WMOD, I_BMOD, I_NORMW, I_WIN, I_WOUT, I_SINK, I_WSP, I_BSP, I_WPOOL, I_PSCALE, I_W1, I_W2 };
#define P_MOD(F)  ((float*)((F).ws + WS_MOD))
#define P_ROPEC(F) ((float*)((F).ws + WS_ROPE))
#define P_ROPES(F) ((float*)((F).ws + WS_ROPE) + SEQ_L * 32)
#define P_O(F)    ((float*)((F).ws + WS_O))
#define P_W1T(F)  ((bf16*)((F).ws + WS_W1T))
#define P_W2T(F)  ((bf16*)((F).ws + WS_W2T))
#define P_WIN(F)  ((bf16*)((F).ws + WS_WIN))
#define P_WOUT(F) ((bf16*)((F).ws + WS_WOUT))
#define P_H(F)    ((bf16*)((F).ws + WS_H))
#define P_A(F)    ((bf16*)((F).ws + WS_A))
#define P_QKV(F)  ((bf16*)((F).ws + WS_QKV))
#define P_MIX(F)  ((bf16*)((F).ws + WS_MIX))

__device__ const double ROPE_INV[16] = {1.0, 0.5623413251903491, 0.31622776601683794, 0.1778279410038923, 0.1, 0.05623413251903491, 0.03162277660168379, 0.01778279410038923,
                                        0.01, 0.005623413251903491, 0.0031622776601683794, 0.0017782794100389228, 0.001, 0.0005623413251903491, 0.00031622776601683794, 0.00017782794100389227};
__device__ __forceinline__ void sincos_d(double x, double& s, double& c) {
    const double kd = __builtin_rint(x * 0.63661977236758134308); const int k = (int)kd;
    double r = __builtin_fma(-kd, 1.57079632679489655800e+00, x); r = __builtin_fma(-kd, 6.12323399573676603587e-17, r);
    const double r2 = r * r;
    const double sp = r * (1.0 + r2 * (-1.0 / 6 + r2 * (1.0 / 120 + r2 * (-1.0 / 5040 + r2 * (1.0 / 362880 + r2 * (-1.0 / 39916800 + r2 * (1.0 / 6227020800.0)))))));
    const double cp = 1.0 + r2 * (-0.5 + r2 * (1.0 / 24 + r2 * (-1.0 / 720 + r2 * (1.0 / 40320 + r2 * (-1.0 / 3628800 + r2 * (1.0 / 479001600 + r2 * (-1.0 / 87178291200.0)))))));
    switch (k & 3) { case 0: s = sp; c = cp; break; case 1: s = cp; c = -sp; break; case 2: s = -sp; c = -cp; break; default: s = -cp; c = sp; break; }
}
__device__ __forceinline__ void phase_mod(Frame& F) {
    frame_refresh(F);
    const float* c_ctx = inp<I_CCTX>(); const float* cvec = inp<I_C>(); const float* w_mod = inp<I_WMOD>(); const float* b_mod = inp<I_BMOD>();
    float* modp = P_MOD(F); float* ropec = P_ROPEC(F); float* ropes = P_ROPES(F);
    LAS float* sil = (LAS float*)F.lds;
    LAS float* part = (LAS float*)(F.lds + 16384);
    for (int i = F.tid; i < 3 * D; i += NWAVES * 64) { const int b = i >> 10, k = i & 1023; const float cv = (b == 0) ? c_ctx[k] : cvec[(b - 1) * D + k]; sil[i] = cv / (1.0f + expf(-cv)); }
    __syncthreads();
    const int ct = F.tid & 15, kg = F.tid >> 4;
    for (int unit = F.vcu; unit < DEPTH * 144; unit += F.G) {
        const int l = unit / 144, cb = unit % 144;
        const float* wp = w_mod + ((size_t)l * D + kg * 32) * (NMOD * D) + cb * 64 + ct * 4;
        f32x4 a0 = {0.f, 0.f, 0.f, 0.f}, a1 = a0, a2 = a0;
#pragma unroll 8
        for (int kk = 0; kk < 32; ++kk) { const f32x4 w = *(const f32x4*)(wp + (size_t)kk * (NMOD * D)); const int k = kg * 32 + kk;
            a0 += sil[k] * w; a1 += sil[D + k] * w; a2 += sil[2 * D + k] * w; }
        *(LAS f32x4*)(part + (kg * 3 + 0) * 64 + ct * 4) = a0; *(LAS f32x4*)(part + (kg * 3 + 1) * 64 + ct * 4) = a1; *(LAS f32x4*)(part + (kg * 3 + 2) * 64 + ct * 4) = a2;
        __syncthreads();
        if (F.tid < 192) { const int b = F.tid >> 6, col = F.tid & 63; float s = 0.f;
#pragma unroll 8
            for (int g = 0; g < 32; ++g) s += part[(g * 3 + b) * 64 + col];
            modp[((size_t)l * 3 + b) * (NMOD * D) + cb * 64 + col] = s + b_mod[(size_t)l * (NMOD * D) + cb * 64 + col]; }
        __syncthreads();
    }
    for (int e = F.vcu * (NWAVES * 64) + F.tid; e < SEQ_L * 32; e += F.G * NWAVES * 64) {
        const int t = e >> 5, ai = e & 31; const double pos = (ai < 16) ? (double)(t >> 6) : (double)(t & 63);
        double s, c; sincos_d(pos * ROPE_INV[ai & 15], s, c); ropec[e] = (float)c; ropes[e] = (float)s;
    }
}

__device__ __forceinline__ void transpose_item(const float* W, int K, int N, bf16* WT, int k0, int n0, int drow0, LAS float* scr, int lane) {
#pragma unroll 8
    for (int i = 0; i < 32; ++i) { const int kk = 2 * i + (lane >> 5); scr[kk * 33 + (lane & 31)] = W[(size_t)(k0 + kk) * N + n0 + (lane & 31)]; }
    LDS_WAIT(); asm volatile("" ::: "memory");
    const int c = lane & 7;
#pragma unroll
    for (int j = 0; j < 4; ++j) { const int n = (lane >> 3) + 8 * j; const LAS float* s = scr + (8 * c) * 33 + n;
        v4u o; o.x = pk2(s[0 * 33], s[1 * 33]); o.y = pk2(s[2 * 33], s[3 * 33]); o.z = pk2(s[4 * 33], s[5 * 33]); o.w = pk2(s[6 * 33], s[7 * 33]);
        *(GAS v4u*)(WT + (size_t)(drow0 + n) * K + k0 + 8 * c) = o; }
    LDS_WAIT(); asm volatile("" ::: "memory");
}
__device__ __forceinline__ int mod_row(int m) { return m < M_CTX ? 0 : 1 + ((m - M_CTX) >> 11); }
__device__ __forceinline__ void prenorm_row(Frame& F, const f32x4 (&v)[4], const float* w_pre, const float* shift, const float* scale, bf16* hrow) {
    float ss = 0.f;
#pragma unroll
    for (int j = 0; j < 4; ++j) ss += (v[j].x * v[j].x + v[j].y * v[j].y) + (v[j].z * v[j].z + v[j].w * v[j].w);
    const float rstd = 1.0f / sqrtf(wave_sum(ss) * (1.0f / D) + EPS);
    GAS unsigned long long* o8 = (GAS unsigned long long*)hrow + F.lane;
#pragma unroll
    for (int j = 0; j < 4; ++j) { const int col = 4 * F.lane + 256 * j; const f32x4 w = *(const f32x4*)(w_pre + col), sh = *(const f32x4*)(shift + col), sc = *(const f32x4*)(scale + col);
        const f32x4 h = (v[j] * rstd * w) * (1.0f + sc) + sh;
        o8[64 * j] = (unsigned long long)pk2(h.x, h.y) | ((unsigned long long)pk2(h.z, h.w) << 32); }
}
__device__ __forceinline__ void phase_pre(Frame& F) {
    frame_refresh(F);
    const float* ffn_w1 = inp<I_W1>(); const float* ffn_w2 = inp<I_W2>(); const float* w_in = inp<I_WIN>(); const float* w_out = inp<I_WOUT>();
    bf16* W1T = P_W1T(F); bf16* W2T = P_W2T(F); bf16* WINp = P_WIN(F); bf16* WOUTp = P_WOUT(F);
    LAS float* scr = (LAS float*)(F.lds + RING_OFF + F.wave * 16384);
    const int gw = F.vcu * NWAVES + F.wave, NGW = F.G * NWAVES;
    constexpr int I_W1 = 16 * 176, I_W2 = 44 * 32, I_IN = 16 * 48, I_OUT = 16 * 32, I_LAYER = 2 * I_W1 + 2 * I_W2 + I_IN + I_OUT;
    for (int it = gw; it < DEPTH * I_LAYER; it += NGW) {
        const int l = it / I_LAYER; int r = it % I_LAYER;
        if (r < 2 * I_W1) { const int f = r / I_W1; r %= I_W1; const int kb = r / 176, nb = r % 176, n0 = 32 * nb;
            const int nn = n0 < DFF ? n0 : n0 - DFF, drow0 = (nn >> 7) * 256 + (n0 < DFF ? 0 : 128) + (nn & 127);
            transpose_item(ffn_w1 + (size_t)(l * 2 + f) * D * (2 * DFF), D, 2 * DFF, W1T + (size_t)(l * 2 + f) * (2 * DFF) * D, 64 * kb, n0, drow0, scr, F.lane); continue; }
        r -= 2 * I_W1;
        if (r < 2 * I_W2) { const int f = r / I_W2; r %= I_W2; const int kb = r / 32, nb = r % 32;
            transpose_item(ffn_w2 + (size_t)(l * 2 + f) * DFF * D, DFF, D, W2T + (size_t)(l * 2 + f) * D * DFF, 64 * kb, 32 * nb, 32 * nb, scr, F.lane); continue; }
        r -= 2 * I_W2;
        if (r < I_IN) { const int kb = r / 48, nb = r % 48;
            transpose_item(w_in + (size_t)l * D * NIN, D, NIN, WINp + (size_t)l * NIN * D, 64 * kb, 32 * nb, 32 * nb, scr, F.lane); continue; }
        r -= I_IN;
        { const int kb = r / 32, nb = r % 32;
            transpose_item(w_out + (size_t)l * D * D, D, D, WOUTp + (size_t)l * D * D, 64 * kb, 32 * nb, 32 * nb, scr, F.lane); }
    }
    const float* x_prompt = inp<I_XP>(); const float* x_sample = inp<I_XS>(); const float* norm_w = inp<I_NORMW>(); const float* modp = P_MOD(F); bf16* Hp = P_H(F);
    for (int m = gw; m < M; m += NGW) {
        const float* xin = m < M_CTX ? x_prompt + (size_t)m * D : x_sample + (size_t)(m - M_CTX) * D;
        const GAS f32x4* xr = (const GAS f32x4*)xin + F.lane; GAS f32x4* xo = (GAS f32x4*)(F.out + (size_t)m * D) + F.lane;
        f32x4 v[4];
#pragma unroll
        for (int j = 0; j < 4; ++j) { v[j] = xr[64 * j]; xo[64 * j] = v[j]; }
        const float* md = modp + (size_t)mod_row(m) * (NMOD * D);
        prenorm_row(F, v, norm_w, md, md + D, Hp + (size_t)m * D);
    }
}

__device__ __forceinline__ void phase_norm(Frame& F, int l, int s) {
    frame_refresh(F);
    const float* norm_w = inp<I_NORMW>(); const float* modp = P_MOD(F); const float* Op = P_O(F); bf16* Hp = P_H(F);
    const int gw = F.vcu * NWAVES + F.wave, NGW = F.G * NWAVES;
    const int jpost = (s == 2) ? 1 : (s == 6) ? 3 : 5, jgate = (s == 2) ? 2 : (s == 6) ? 5 : 8;
    const float gs = (s == 6) ? 1.0f : 0.5f;
    const bool has_next = !(s == 9 && l == DEPTH - 1);
    const int ln = (s == 9) ? l + 1 : l, jpre = (s == 2) ? 2 : (s == 6) ? 4 : 0, jshift = (s == 2) ? 3 : (s == 6) ? 6 : 0;
    const float* w_post = norm_w + ((size_t)l * 6 + jpost) * D;
    for (int m = gw; m < M; m += NGW) {
        const int mr = mod_row(m);
        const float* gate = modp + ((size_t)(l * 3 + mr) * NMOD + jgate) * D;
        const GAS f32x4* orow = (const GAS f32x4*)(Op + (size_t)m * D) + F.lane; GAS f32x4* xrow = (GAS f32x4*)(F.out + (size_t)m * D) + F.lane;
        f32x4 o[4], v[4]; float ss = 0.f;
#pragma unroll
        for (int j = 0; j < 4; ++j) { o[j] = orow[64 * j]; v[j] = xrow[64 * j]; ss += (o[j].x * o[j].x + o[j].y * o[j].y) + (o[j].z * o[j].z + o[j].w * o[j].w); }
        const float rstd = 1.0f / sqrtf(wave_sum(ss) * (1.0f / D) + EPS);
#pragma unroll
        for (int j = 0; j < 4; ++j) { const int col = 4 * F.lane + 256 * j; const f32x4 w = *(const f32x4*)(w_post + col), g = *(const f32x4*)(gate + col);
            v[j] = v[j] + (gs * g) * (o[j] * rstd * w); xrow[64 * j] = v[j]; }
        if (has_next) {
            const float* mdn = modp + ((size_t)(ln * 3 + mr) * NMOD + jshift) * D;
            prenorm_row(F, v, norm_w + ((size_t)ln * 6 + jpre) * D, mdn, mdn + D, Hp + (size_t)m * D);
        }
    }
}

__device__ __forceinline__ void load8bf(const bf16* p, float (&f)[8]) {
    const v4u r = *(const v4u*)p;
    f[0] = __uint_as_float(r.x << 16); f[1] = __uint_as_float(r.x & 0xffff0000u); f[2] = __uint_as_float(r.y << 16); f[3] = __uint_as_float(r.y & 0xffff0000u);
    f[4] = __uint_as_float(r.z << 16); f[5] = __uint_as_float(r.z & 0xffff0000u); f[6] = __uint_as_float(r.w << 16); f[7] = __uint_as_float(r.w & 0xffff0000u);
}
__device__ __forceinline__ void mix_row_naive(Frame& F, int l, int m) {
    const int lane = F.lane;
    const float* cache_k = inp<I_CK>(); const float* cache_v = inp<I_CV>(); const float* attn_sink = inp<I_SINK>(); const float* w_spatial = inp<I_WSP>(); const float* b_spatial = inp<I_BSP>();
    const float* w_pool = inp<I_WPOOL>(); const float* pool_scale = inp<I_PSCALE>(); const float* ropec = P_ROPEC(F); const float* ropes = P_ROPES(F); const bf16* QKV = P_QKV(F); bf16* MIX = P_MIX(F);
    LAS float* qs = (LAS float*)(F.lds + F.wave * 4096); LAS float* sc = qs + 64;
    const bool lat = m >= M_CTX;
    int bl = 0, t, seq0, S;
    if (!lat) { t = m & 255; seq0 = m & ~255; S = SEQ_C; } else { const int r = m - M_CTX; bl = r >> 11; t = r & 2047; seq0 = M_CTX + (bl << 11); S = SEQ_L; }
    const bf16* qrow = QKV + (size_t)m * NIN;
    for (int hq = 0; hq < 8; ++hq) {
        const int kv = hq >> 2;
        float qv = bf2f(qrow[hq * 64 + lane]);
        if (lat) { const float pv = __shfl_xor(qv, 16); const int ai = (lane & 15) + ((lane >> 5) << 4); const float cs = ropec[t * 32 + ai], sn = ropes[t * 32 + ai];
            qv = (lane & 16) ? qv * cs + pv * sn : qv * cs - pv * sn; }
        qs[lane] = qv;
        LDS_WAIT(); asm volatile("" ::: "memory");
        int j0 = 0, nband = 0, nkeys = SEQ_C;
        if (lat) { j0 = t - 128 < 0 ? 0 : t - 128; const int j1 = t + 128 > SEQ_L - 1 ? SEQ_L - 1 : t + 128; nband = j1 - j0 + 1; nkeys = nband + PAST; }
        float mx = -3.0e38f;
        for (int idx = lane; idx < nkeys; idx += 64) {
            float dot = 0.f;
            if (!lat) {
                const bf16* kp = QKV + (size_t)(seq0 + idx) * NIN + 512 + kv * 64;
#pragma unroll
                for (int c8 = 0; c8 < 8; ++c8) { float kf[8]; load8bf(kp + 8 * c8, kf);
#pragma unroll
                    for (int e = 0; e < 8; ++e) dot += qs[8 * c8 + e] * kf[e]; }
            } else if (idx < nband) {
                const int kt = j0 + idx; const bf16* kp = QKV + (size_t)(seq0 + kt) * NIN + 512 + kv * 64;
                float kf[64];
#pragma unroll
                for (int c8 = 0; c8 < 8; ++c8) { float t8[8]; load8bf(kp + 8 * c8, t8);
#pragma unroll
                    for (int e = 0; e < 8; ++e) kf[8 * c8 + e] = t8[e]; }
#pragma unroll
                for (int a = 0; a < 2; ++a)
#pragma unroll
                    for (int d = 0; d < 16; ++d) { const float cs = ropec[kt * 32 + a * 16 + d], sn = ropes[kt * 32 + a * 16 + d]; const float z1 = kf[a * 32 + d], z2 = kf[a * 32 + 16 + d];
                        dot += qs[a * 32 + d] * (z1 * cs - z2 * sn) + qs[a * 32 + 16 + d] * (z2 * cs + z1 * sn); }
            } else {
                const float* kp = cache_k + ((((size_t)bl * DEPTH + l) * PAST + (idx - nband)) * 2 + kv) * 64;
#pragma unroll
                for (int c4 = 0; c4 < 16; ++c4) { const f32x4 k4 = *(const f32x4*)(kp + 4 * c4);
                    dot += qs[4 * c4] * k4.x + qs[4 * c4 + 1] * k4.y + qs[4 * c4 + 2] * k4.z + qs[4 * c4 + 3] * k4.w; }
            }
            const float sv = dot * 0.125f; sc[idx] = sv; mx = fmaxf(mx, sv);
        }
        const float sink = attn_sink[l * 8 + hq];
        mx = fmaxf(wave_max(mx), sink);
        float sum = 0.f;
        for (int idx = lane; idx < nkeys; idx += 64) { const float p = expf(sc[idx] - mx); sc[idx] = p; sum += p; }
        const float denom = wave_sum(sum) + expf(sink - mx);
        LDS_WAIT(); asm volatile("" ::: "memory");
        float acc = 0.f;
        for (int idx = 0; idx < nkeys; ++idx) {
            float vv;
            if (!lat || idx < nband) vv = bf2f(QKV[(size_t)(seq0 + j0 + idx) * NIN + 640 + kv * 64 + lane]);
            else vv = cache_v[((((size_t)bl * DEPTH + l) * PAST + (idx - nband)) * 2 + kv) * 64 + lane];
            acc += sc[idx] * vv;
        }
        MIX[(size_t)m * D + hq * 64 + lane] = (bf16)f2bf(acc / denom);
        LDS_WAIT(); asm volatile("" ::: "memory");
    }
    const int cb = m & ~127, p = m & 127;
    for (int h = 0; h < 4; ++h) {
        float r0, r1;
        { float ss0 = 0.f, ss1 = 0.f; const bf16* v0 = QKV + (size_t)(cb + lane) * NIN + 1024 + h * 64; const bf16* v1 = v0 + (size_t)64 * NIN;
#pragma unroll
            for (int c8 = 0; c8 < 8; ++c8) { float a[8], b[8]; load8bf(v0 + 8 * c8, a); load8bf(v1 + 8 * c8, b);
#pragma unroll
                for (int e = 0; e < 8; ++e) { ss0 += a[e] * a[e]; ss1 += b[e] * b[e]; } }
            r0 = 1.0f / sqrtf(ss0 * (1.0f / 64) + EPS); r1 = 1.0f / sqrtf(ss1 * (1.0f / 64) + EPS); }
        const float* wrow = w_spatial + (((size_t)l * 4 + h) * 128 + p) * 128;
        float z = 0.f;
        for (int q = 0; q < 128; ++q) { const float rq = __shfl(q < 64 ? r0 : r1, q & 63);
            z += wrow[q] * (rq * bf2f(QKV[(size_t)(cb + q) * NIN + 1024 + h * 64 + lane])); }
        z += b_spatial[((size_t)l * 4 + h) * 128 + p];
        const float gu = bf2f(qrow[768 + h * 64 + lane]);
        MIX[(size_t)m * D + 512 + h * 64 + lane] = (bf16)f2bf(gu * z);
    }
    for (int g = 0; g < 4; ++g) {
        const int w = 2 << g; const int lo = t - w / 2 < 0 ? 0 : t - w / 2, hi = t + w / 2 > S ? S : t + w / 2;
        float sum = 0.f;
        for (int tt = lo; tt < hi; ++tt) sum += bf2f(QKV[(size_t)(seq0 + tt) * NIN + 1280 + g * 64 + lane]);
        const float dv = sum / (float)(hi - lo) - bf2f(qrow[1280 + g * 64 + lane]);
        const float* wp = w_pool + ((size_t)l * 4 + g) * 64 * 64;
        float o = 0.f;
        for (int i = 0; i < 64; ++i) o += __shfl(dv, i) * wp[i * 64 + lane];
        MIX[(size_t)m * D + 768 + g * 64 + lane] = (bf16)f2bf(o * pool_scale[l * 256 + g * 64 + lane]);
    }
    if (!lat) { const int b = m >> 8; float* ok = F.out + (size_t)M * D + (((size_t)b * DEPTH + l) * SEQ_C + t) * 128; float* ov = ok + (size_t)32 * DEPTH * SEQ_C * 128;
        ok[lane] = bf2f(qrow[512 + lane]); ok[64 + lane] = bf2f(qrow[576 + lane]); ov[lane] = bf2f(qrow[640 + lane]); ov[64 + lane] = bf2f(qrow[704 + lane]); }
}
__device__ __forceinline__ void phase_mix(Frame& F, int l) {
    frame_refresh(F);
    const int gw = F.vcu * NWAVES + F.wave, NGW = F.G * NWAVES;
    for (int m = gw; m < M; m += NGW) mix_row_naive(F, l, m);
}


typedef float f32x16 __attribute__((ext_vector_type(16)));
typedef short s16x4 __attribute__((ext_vector_type(4)));
constexpr int KS_PITCH = 144, VT_PITCH = 136, KBUF_B = 64 * KS_PITCH, VBUF_B = 64 * VT_PITCH;
constexpr int ATT_V_OFF = 2 * KBUF_B;
constexpr float SM_C = 0.125f * 1.4426950408889634f;
__device__ __forceinline__ v4u pack8(const float (&f)[8]) { v4u r; r.x = pk2(f[0], f[1]); r.y = pk2(f[2], f[3]); r.z = pk2(f[4], f[5]); r.w = pk2(f[6], f[7]); return r; }
__device__ __forceinline__ void unpack8(const v4u r, float (&f)[8]) {
    f[0] = __uint_as_float(r.x << 16); f[1] = __uint_as_float(r.x & 0xffff0000u); f[2] = __uint_as_float(r.y << 16); f[3] = __uint_as_float(r.y & 0xffff0000u);
    f[4] = __uint_as_float(r.z << 16); f[5] = __uint_as_float(r.z & 0xffff0000u); f[6] = __uint_as_float(r.w << 16); f[7] = __uint_as_float(r.w & 0xffff0000u);
}
__device__ __forceinline__ unsigned pk2u(unsigned lo, unsigned hi) { return pk2(__uint_as_float(lo), __uint_as_float(hi)); }
__device__ __forceinline__ void load8f(const GAS float* p, float (&f)[8]) { const f32x4 a = *(const GAS f32x4*)p, b = *(const GAS f32x4*)(p + 4); f[0] = a.x; f[1] = a.y; f[2] = a.z; f[3] = a.w; f[4] = b.x; f[5] = b.y; f[6] = b.z; f[7] = b.w; }
__device__ __forceinline__ void vt_store(LAS unsigned char* vb, int key, int c, const v4u r) {
    LAS unsigned short* p = (LAS unsigned short*)(vb + (8 * c) * VT_PITCH + 2 * key);
    p[0 * (VT_PITCH / 2)] = (unsigned short)(r.x & 0xffffu); p[1 * (VT_PITCH / 2)] = (unsigned short)(r.x >> 16); p[2 * (VT_PITCH / 2)] = (unsigned short)(r.y & 0xffffu); p[3 * (VT_PITCH / 2)] = (unsigned short)(r.y >> 16);
    p[4 * (VT_PITCH / 2)] = (unsigned short)(r.z & 0xffffu); p[5 * (VT_PITCH / 2)] = (unsigned short)(r.z >> 16); p[6 * (VT_PITCH / 2)] = (unsigned short)(r.w & 0xffffu); p[7 * (VT_PITCH / 2)] = (unsigned short)(r.w >> 16);
}
__device__ __forceinline__ void attn_unit(Frame& F, int l, bool lat, int u) {
    const GAS float* cache_k = (const GAS float*)inp<I_CK>(); const GAS float* cache_v = (const GAS float*)inp<I_CV>();
    const GAS float* ropec = (const GAS float*)P_ROPEC(F); const GAS float* ropes = (const GAS float*)P_ROPES(F);
    const GAS bf16* QKV = (const GAS bf16*)P_QKV(F); GAS bf16* MIX = (GAS bf16*)P_MIX(F);
    const int tid = F.tid, lane = F.lane, wave = F.wave, r32 = lane & 31, hi = lane >> 5;
    LAS unsigned char* lds = F.lds;
    int hq, kv, qrow, qpos = 0, seq0, nband, kt0 = 0, ntiles, bl = 0;
    if (!lat) { const int b = u >> 3; hq = u & 7; kv = hq >> 2; seq0 = b * SEQ_C; qrow = seq0 + wave * 32 + r32; nband = 4; ntiles = 4; }
    else { const int hp = u & 1; kv = (u >> 1) & 1; const int qblk = (u >> 2) & 15; bl = u >> 6; hq = 4 * kv + 2 * hp + (wave >> 2); seq0 = M_CTX + bl * SEQ_L;
        qpos = qblk * 128 + (wave & 3) * 32 + r32; qrow = seq0 + qpos;
        kt0 = qblk * 128 - 128 < 0 ? 0 : qblk * 128 - 128; const int kt1 = qblk * 128 + 256 > SEQ_L ? SEQ_L : qblk * 128 + 256; nband = (kt1 - kt0) >> 6; ntiles = nband + PAST / 64; }
    const float sinkl = inp<I_SINK>()[l * 8 + hq] * 1.4426950408889634f;
    bf16x8 qf[4];
    { const GAS bf16* qp = QKV + (size_t)qrow * NIN + hq * 64 + 8 * hi;
        v4u raw[4];
#pragma unroll
        for (int s = 0; s < 4; ++s) raw[s] = *(const GAS v4u*)(qp + 16 * s);
        if (lat) {
#pragma unroll
            for (int a = 0; a < 2; ++a) { float z1[8], z2[8], cs[8], sn[8]; unpack8(raw[2 * a], z1); unpack8(raw[2 * a + 1], z2);
                const GAS float* cp = ropec + (size_t)qpos * 32 + 16 * a + 8 * hi; const GAS float* sp = ropes + (size_t)qpos * 32 + 16 * a + 8 * hi;
                load8f(cp, cs); load8f(sp, sn);
                float o1[8], o2[8];
#pragma unroll
                for (int e = 0; e < 8; ++e) { o1[e] = z1[e] * cs[e] - z2[e] * sn[e]; o2[e] = z2[e] * cs[e] + z1[e] * sn[e]; }
                raw[2 * a] = pack8(o1); raw[2 * a + 1] = pack8(o2); }
        }
#pragma unroll
        for (int s = 0; s < 4; ++s) qf[s] = __builtin_bit_cast(bf16x8, raw[s]);
    }
    const int skey = tid >> 3, sc = tid & 7;
    v4u kx = {0, 0, 0, 0}, ky = {0, 0, 0, 0}, vx = {0, 0, 0, 0}, wx = {0, 0, 0, 0};
    const GAS float* ckb = cache_k + (((size_t)bl * DEPTH + l) * PAST * 2 + kv) * 64 + 8 * sc;
    const GAS float* cvb = cache_v + (((size_t)bl * DEPTH + l) * PAST * 2 + kv) * 64 + 8 * sc;
    float* ocache = nullptr;
    if (!lat && (hq & 3) == 0) ocache = F.out + (size_t)M * D + (((size_t)(u >> 3) * DEPTH + l) * SEQ_C) * 128 + kv * 64 + 8 * sc;
#define ATT_LOAD(t) do { if ((t) < nband) { const int krow_ = seq0 + kt0 + 64 * (t) + skey; const GAS bf16* kp_ = QKV + (size_t)krow_ * NIN + 512 + kv * 64; \
            kx = *(const GAS v4u*)(kp_ + 8 * sc); if (lat) ky = *(const GAS v4u*)(kp_ + 8 * (sc ^ 2)); vx = *(const GAS v4u*)(kp_ + 128 + 8 * sc); } \
        else { const int key_ = 64 * ((t) - nband) + skey; kx = *(const GAS v4u*)(ckb + (size_t)key_ * 128); ky = *(const GAS v4u*)(ckb + (size_t)key_ * 128 + 4); \
            vx = *(const GAS v4u*)(cvb + (size_t)key_ * 128); wx = *(const GAS v4u*)(cvb + (size_t)key_ * 128 + 4); } } while (0)
#define ATT_STORE(t) do { LAS unsigned char* kb_ = lds + (((t) & 1) ? KBUF_B : 0); LAS unsigned char* vb_ = lds + ATT_V_OFF + (((t) & 1) ? VBUF_B : 0); v4u kw_, vw_; \
        if ((t) < nband) { kw_ = kx; vw_ = vx; \
            if (lat) { const int kt_ = kt0 + 64 * (t) + skey; float x_[8], y_[8], cs_[8], sn_[8]; unpack8(kx, x_); unpack8(ky, y_); \
                const GAS float* cp_ = ropec + (size_t)kt_ * 32 + 16 * (sc >> 2) + 8 * (sc & 1); const GAS float* sp_ = ropes + (size_t)kt_ * 32 + 16 * (sc >> 2) + 8 * (sc & 1); \
                load8f(cp_, cs_); load8f(sp_, sn_); \
                const float sg_ = (sc & 2) ? 1.0f : -1.0f; float o_[8]; \
                _Pragma("unroll") for (int e = 0; e < 8; ++e) o_[e] = x_[e] * cs_[e] + sg_ * (y_[e] * sn_[e]); \
                kw_ = pack8(o_); } \
            if (ocache) { float x_[8], y_[8]; unpack8(kx, x_); unpack8(vx, y_); float* ok_ = ocache + (size_t)(64 * (t) + skey) * 128; float* ov_ = ok_ + (size_t)32 * DEPTH * SEQ_C * 128; \
                *(f32x4*)ok_ = (f32x4){x_[0], x_[1], x_[2], x_[3]}; *(f32x4*)(ok_ + 4) = (f32x4){x_[4], x_[5], x_[6], x_[7]}; *(f32x4*)ov_ = (f32x4){y_[0], y_[1], y_[2], y_[3]}; *(f32x4*)(ov_ + 4) = (f32x4){y_[4], y_[5], y_[6], y_[7]}; } } \
        else { kw_.x = pk2u(kx.x, kx.y); kw_.y = pk2u(kx.z, kx.w); kw_.z = pk2u(ky.x, ky.y); kw_.w = pk2u(ky.z, ky.w); vw_.x = pk2u(vx.x, vx.y); vw_.y = pk2u(vx.z, vx.w); vw_.z = pk2u(wx.x, wx.y); vw_.w = pk2u(wx.z, wx.w); } \
        *(LAS v4u*)(kb_ + skey * KS_PITCH + 16 * sc) = kw_; vt_store(vb_, skey, sc, vw_); } while (0)
    float m_run = sinkl, l_run = hi ? 0.0f : 1.0f;
    f32x16 o0, o1;
#pragma unroll
    for (int r = 0; r < 16; ++r) { o0[r] = 0.f; o1[r] = 0.f; }
    ATT_LOAD(0); ATT_STORE(0);
    LDS_WAIT(); __syncthreads();
    for (int t = 0; t < ntiles; ++t) {
        if (t + 1 < ntiles) ATT_LOAD(t + 1);
        bool active = true, need_mask = false; int k0 = 0;
        if (lat && t < nband) { k0 = kt0 + 64 * t; const int q0 = qpos - r32;
            active = !(k0 + 63 < q0 - 128 || k0 > q0 + 31 + 128); need_mask = !(k0 >= q0 + 31 - 128 && k0 + 63 <= q0 + 128); }
        if (active) {
            const LAS unsigned char* kb = lds + ((t & 1) ? KBUF_B : 0) + r32 * KS_PITCH + 16 * hi; const LAS unsigned char* vb = lds + ATT_V_OFF + ((t & 1) ? VBUF_B : 0) + r32 * VT_PITCH + 8 * hi;
            f32x16 s0, s1;
#pragma unroll
            for (int r = 0; r < 16; ++r) { s0[r] = 0.f; s1[r] = 0.f; }
#pragma unroll
            for (int s = 0; s < 4; ++s) { const bf16x8 a0 = *(const LAS bf16x8*)(kb + 32 * s), a1 = *(const LAS bf16x8*)(kb + 32 * KS_PITCH + 32 * s);
                s0 = __builtin_amdgcn_mfma_f32_32x32x16_bf16(a0, qf[s], s0, 0, 0, 0); s1 = __builtin_amdgcn_mfma_f32_32x32x16_bf16(a1, qf[s], s1, 0, 0, 0); }
            if (need_mask) {
#pragma unroll
                for (int r = 0; r < 16; ++r) { const int kp = k0 + (r & 3) + 8 * (r >> 2) + 4 * hi; const int d0 = qpos - kp, d1 = d0 - 32;
                    if (d0 > 128 || d0 < -128) s0[r] = -INFINITY; if (d1 > 128 || d1 < -128) s1[r] = -INFINITY; } }
            float mx = fmaxf(s0[0], s1[0]);
#pragma unroll
            for (int r = 1; r < 16; ++r) mx = fmaxf(mx, fmaxf(s0[r], s1[r]));
            mx = fmaxf(mx, __shfl_xor(mx, 32));
            const float mnew = fmaxf(m_run, mx * SM_C), alpha = __builtin_amdgcn_exp2f(m_run - mnew); m_run = mnew;
            float ps = 0.f;
#pragma unroll
            for (int r = 0; r < 16; ++r) { s0[r] = __builtin_amdgcn_exp2f(__builtin_fmaf(s0[r], SM_C, -mnew)); s1[r] = __builtin_amdgcn_exp2f(__builtin_fmaf(s1[r], SM_C, -mnew)); ps += s0[r] + s1[r]; o0[r] *= alpha; o1[r] *= alpha; }
            l_run = l_run * alpha + ps;
            v4u pw[4];
            pw[0].x = pk2(s0[0], s0[1]); pw[0].y = pk2(s0[2], s0[3]); pw[0].z = pk2(s0[4], s0[5]); pw[0].w = pk2(s0[6], s0[7]);
            pw[1].x = pk2(s0[8], s0[9]); pw[1].y = pk2(s0[10], s0[11]); pw[1].z = pk2(s0[12], s0[13]); pw[1].w = pk2(s0[14], s0[15]);
            pw[2].x = pk2(s1[0], s1[1]); pw[2].y = pk2(s1[2], s1[3]); pw[2].z = pk2(s1[4], s1[5]); pw[2].w = pk2(s1[6], s1[7]);
            pw[3].x = pk2(s1[8], s1[9]); pw[3].y = pk2(s1[10], s1[11]); pw[3].z = pk2(s1[12], s1[13]); pw[3].w = pk2(s1[14], s1[15]);
#pragma unroll
            for (int ks = 0; ks < 4; ++ks) {
                const s16x4 a_lo = *(const LAS s16x4*)(vb + 32 * ks), a_hi = *(const LAS s16x4*)(vb + 32 * ks + 16);
                const s16x4 b_lo = *(const LAS s16x4*)(vb + 32 * VT_PITCH + 32 * ks), b_hi = *(const LAS s16x4*)(vb + 32 * VT_PITCH + 32 * ks + 16);
                const bf16x8 va = (bf16x8){a_lo[0], a_lo[1], a_lo[2], a_lo[3], a_hi[0], a_hi[1], a_hi[2], a_hi[3]}, vbb = (bf16x8){b_lo[0], b_lo[1], b_lo[2], b_lo[3], b_hi[0], b_hi[1], b_hi[2], b_hi[3]};
                const bf16x8 pf = __builtin_bit_cast(bf16x8, pw[ks]);
                o0 = __builtin_amdgcn_mfma_f32_32x32x16_bf16(va, pf, o0, 0, 0, 0); o1 = __builtin_amdgcn_mfma_f32_32x32x16_bf16(vbb, pf, o1, 0, 0, 0); }
        }
        if (t + 1 < ntiles) ATT_STORE(t + 1);
        LDS_WAIT(); __syncthreads();
    }
#undef ATT_LOAD
#undef ATT_STORE
    const float inv = 1.0f / (l_run + __shfl_xor(l_run, 32));
    GAS bf16* op = MIX + (size_t)qrow * D + hq * 64 + 4 * hi;
#pragma unroll
    for (int g = 0; g < 4; ++g) {
        *(GAS unsigned long long*)(op + 8 * g) = (unsigned long long)pk2(o0[4 * g] * inv, o0[4 * g + 1] * inv) | ((unsigned long long)pk2(o0[4 * g + 2] * inv, o0[4 * g + 3] * inv) << 32);
        *(GAS unsigned long long*)(op + 32 + 8 * g) = (unsigned long long)pk2(o1[4 * g] * inv, o1[4 * g + 1] * inv) | ((unsigned long long)pk2(o1[4 * g + 2] * inv, o1[4 * g + 3] * inv) << 32); }
}

constexpr int VG_PITCH = 272, PL_PITCH = 528, WPT_PITCH = 144, PL_BYTES = 144 * PL_PITCH;
__device__ __forceinline__ void other_unit(Frame& F, int l, int rb) {
    const GAS bf16* QKV = (const GAS bf16*)P_QKV(F); GAS bf16* MIX = (GAS bf16*)P_MIX(F);
    const int tid = F.tid, lane = F.lane, wave = F.wave, fr = lane & 15, fq = lane >> 4;
    LAS unsigned char* lds = F.lds;
    const int t0 = rb * 128;
#pragma unroll 2
    for (int it = 0; it < 8; ++it) { const int qh = it * 64 + (tid >> 3), c = tid & 7, q = qh >> 2, h = qh & 3;
        float v[8]; unpack8(*(const GAS v4u*)(QKV + (size_t)(t0 + q) * NIN + 1024 + h * 64 + 8 * c), v);
        float ss = 0.f;
#pragma unroll
        for (int e = 0; e < 8; ++e) ss += v[e] * v[e];
        ss += __shfl_xor(ss, 1); ss += __shfl_xor(ss, 2); ss += __shfl_xor(ss, 4);
        const float r = 1.0f / sqrtf(ss * (1.0f / 64) + EPS);
        LAS unsigned short* p = (LAS unsigned short*)(lds + (h * 64 + 8 * c) * VG_PITCH + 2 * q);
#pragma unroll
        for (int e = 0; e < 8; ++e) p[e * (VG_PITCH / 2)] = (unsigned short)f2bf(v[e] * r); }
    LDS_WAIT(); __syncthreads();
    { const GAS float* w_spatial = (const GAS float*)inp<I_WSP>(); const GAS float* b_spatial = (const GAS float*)inp<I_BSP>();
        for (int h = 0; h < 4; ++h) {
            f32x4 acc[4];
#pragma unroll
            for (int nb = 0; nb < 4; ++nb) acc[nb] = (f32x4){0.f, 0.f, 0.f, 0.f};
            const GAS float* wrow = w_spatial + (((size_t)l * 4 + h) * 128 + 16 * wave + fr) * 128 + 8 * fq;
#pragma unroll
            for (int ks = 0; ks < 4; ++ks) { float wf[8]; load8f(wrow + 32 * ks, wf); const bf16x8 a = __builtin_bit_cast(bf16x8, pack8(wf));
#pragma unroll
                for (int nb = 0; nb < 4; ++nb) { const bf16x8 b = *(const LAS bf16x8*)(lds + (h * 64 + 16 * nb + fr) * VG_PITCH + 64 * ks + 16 * fq);
                    acc[nb] = __builtin_amdgcn_mfma_f32_16x16x32_bf16(a, b, acc[nb], 0, 0, 0); } }
#pragma unroll
            for (int reg = 0; reg < 4; ++reg) { const int p = 16 * wave + 4 * fq + reg; const float bs = b_spatial[((size_t)l * 4 + h) * 128 + p];
#pragma unroll
                for (int nb = 0; nb < 4; ++nb) { const int d = 16 * nb + fr; const float gu = bf2f(QKV[(size_t)(t0 + p) * NIN + 768 + h * 64 + d]);
                    MIX[(size_t)(t0 + p) * D + 512 + h * 64 + d] = (bf16)f2bf(gu * (acc[nb][reg] + bs)); } }
        }
    }
    __syncthreads();
    const bool latb = t0 >= M_CTX; const int S = latb ? SEQ_L : SEQ_C; const int seq0 = latb ? M_CTX + (((t0 - M_CTX) >> 11) << 11) : (t0 & ~255); const int p0 = t0 - seq0 - 8;
    for (int it = 0; it < 9; ++it) { const int item = it * 512 + tid, row = item >> 5, ch = item & 31, pos = p0 + row;
        if (pos >= 0 && pos < S) *(LAS v4u*)(lds + row * PL_PITCH + 16 * ch) = *(const GAS v4u*)(QKV + (size_t)(seq0 + pos) * NIN + 1280 + 8 * ch); }
    { const GAS float* w_pool = (const GAS float*)inp<I_WPOOL>();
#pragma unroll
        for (int it = 0; it < 4; ++it) { const int item = it * 512 + tid, gi = item >> 3, jc = item & 7;
            float wf[8]; load8f(w_pool + ((size_t)l * 256 + gi) * 64 + 8 * jc, wf);
            LAS unsigned short* p = (LAS unsigned short*)(lds + PL_BYTES + ((gi >> 6) * 64 + 8 * jc) * WPT_PITCH + 2 * (gi & 63));
#pragma unroll
            for (int e = 0; e < 8; ++e) p[e * (WPT_PITCH / 2)] = (unsigned short)f2bf(wf[e]); } }
    LDS_WAIT(); __syncthreads();
    { const GAS float* pool_scale = (const GAS float*)inp<I_PSCALE>();
        const int trow = 16 * wave + fr, tpos = t0 - seq0 + trow;
        for (int g = 0; g < 4; ++g) {
            const int wh = 1 << g; const int lo = tpos - wh < 0 ? 0 : tpos - wh, hi2 = tpos + wh > S ? S : tpos + wh; const float rinv = 1.0f / (float)(hi2 - lo);
            f32x4 acc[4];
#pragma unroll
            for (int nb = 0; nb < 4; ++nb) acc[nb] = (f32x4){0.f, 0.f, 0.f, 0.f};
#pragma unroll
            for (int ks = 0; ks < 2; ++ks) {
                const LAS unsigned char* colp = lds + 2 * (64 * g + 32 * ks + 8 * fq);
                float sum[8];
#pragma unroll
                for (int e = 0; e < 8; ++e) sum[e] = 0.f;
                for (int pp = lo; pp < hi2; ++pp) { float x[8]; unpack8(*(const LAS v4u*)(colp + (pp - p0) * PL_PITCH), x);
#pragma unroll
                    for (int e = 0; e < 8; ++e) sum[e] += x[e]; }
                float self[8]; unpack8(*(const LAS v4u*)(colp + (tpos - p0) * PL_PITCH), self);
                float dv[8];
#pragma unroll
                for (int e = 0; e < 8; ++e) dv[e] = sum[e] * rinv - self[e];
                const bf16x8 a = __builtin_bit_cast(bf16x8, pack8(dv));
#pragma unroll
                for (int nb = 0; nb < 4; ++nb) { const bf16x8 b = *(const LAS bf16x8*)(lds + PL_BYTES + (g * 64 + 16 * nb + fr) * WPT_PITCH + 64 * ks + 16 * fq);
                    acc[nb] = __builtin_amdgcn_mfma_f32_16x16x32_bf16(a, b, acc[nb], 0, 0, 0); } }
#pragma unroll
            for (int nb = 0; nb < 4; ++nb) { const int j = 64 * g + 16 * nb + fr; const float ps = pool_scale[l * 256 + j];
#pragma unroll
                for (int reg = 0; reg < 4; ++reg) MIX[(size_t)(t0 + 16 * wave + 4 * fq + reg) * D + 768 + j] = (bf16)f2bf(acc[nb][reg] * ps); }
        }
    }
    __syncthreads();
}
__device__ __forceinline__ void phase_mix_fast(Frame& F, int l) {
    frame_refresh(F);
    for (int slot = F.vcu; slot < 768; slot += F.G) {
        const bool is_att = slot < 256 || (slot >= 384 && slot < 512);
        if (is_att) attn_unit(F, l, slot < 128, slot < 128 ? slot : (slot < 256 ? slot - 128 : slot - 256));
        else if (slot >= 640 && slot < 736) other_unit(F, l, slot - 640);
    }
}

struct Args { const float* in[18]; float* out; unsigned char* ws; int ph_lo, ph_hi, li, pad; };
__global__ void __launch_bounds__(NWAVES * 64, 2) mk_fwd(Args args) {
    extern __shared__ __attribute__((aligned(16))) unsigned char lds[];
    Frame F;
    F.lds = (LAS unsigned char*)lds;
    F.tid = threadIdx.x; F.lane = F.tid & 63; F.wave = __builtin_amdgcn_readfirstlane(F.tid >> 6);
    F.G = gridDim.x; { const int bx = blockIdx.x; F.vcu = (F.G % 8 == 0) ? (bx % 8) * (F.G / 8) + bx / 8 : bx; }
    unsigned char* ws = args.ws;
    F.ws = ws; F.out = args.out;
    volatile LAS unsigned* MISC = (volatile LAS unsigned*)(F.lds + MISC_OFF);
    for (int u = F.tid; u < (LDS_BYTES - LDSCTL_OFF) / 4; u += NWAVES * 64) ((LAS unsigned*)(F.lds + LDSCTL_OFF))[u] = 0u;
    __syncthreads();
    XcdBarrier bar; bar.bar = (unsigned*)(ws + WS_CTL) + CW_BAR; bar.x = 0; bar.st = nullptr;
    if (N_LAUNCHES == 1) bar = xcd_barrier_post((unsigned*)(ws + WS_CTL) + CW_BAR, MISC + 8);

    for (int ph = args.ph_lo; ph < args.ph_hi; ++ph) {
        if (ph == 0) phase_mod(F);
        if (ph == 1) phase_pre(F);
        if (ph >= 2) {
            const int q = ph - 2, l = q / 10, s = q % 10;
            if (s == 0 || s == 7) {
                const int f = (s == 7) ? 1 : 0;
                pg8::Gemm g{P_H(F), P_W1T(F) + (size_t)(l * 2 + f) * (2 * DFF) * D, M, 2 * DFF, D}; pg8::StaticOrder S; S.init(M, 2 * DFF, F.G, (int)blockIdx.x);
                pg8::EpiSwiglu E{P_A(F), DFF};
                pg8::gemm_phase<pg8::EpiSwiglu, pg8::StaticOrder, true, true>(F.lds + RING_OFF, g, S, E);
            } else if (s == 1 || s == 8 || s == 5) {
                const int f = (s == 8) ? 1 : 0;
                pg8::Gemm g{P_A(F), P_W2T(F) + (size_t)(l * 2 + f) * D * DFF, M, D, DFF};
                if (s == 5) { g.A = P_MIX(F); g.Bt = P_WOUT(F) + (size_t)l * D * D; g.K = D; }
                pg8::StaticOrder S; S.init(M, D, F.G, (int)blockIdx.x);
                pg8::EpiF32 E{P_O(F), D};
                pg8::gemm_phase<pg8::EpiF32, pg8::StaticOrder, true, true>(F.lds + RING_OFF, g, S, E);
            } else if (s == 3) {
                pg8::Gemm g{P_H(F), P_WIN(F) + (size_t)l * NIN * D, M, NIN, D}; pg8::StaticOrder S; S.init(M, NIN, F.G, (int)blockIdx.x);
                pg8::EpiBf16P E{P_QKV(F), NIN};
                pg8::gemm_phase<pg8::EpiBf16P, pg8::StaticOrder, true, true>(F.lds + RING_OFF, g, S, E);
            } else if (s == 4) {
#if MK_NAIVE_MIX
                phase_mix(F, l);
#else
                phase_mix_fast(F, l);
#endif
            } else {
                phase_norm(F, l, s);
            }
        }
        if (ph + 1 < args.ph_hi) xcd_barrier(bar);
    }
}

extern "C" void kernel_launch(void* const* d_in, const int* in_sizes, int n_in, void* d_out, int out_size, void* d_ws, size_t ws_size, hipStream_t stream) {
    static int grid = 0;
    if (grid == 0) {
        if (n_in != 18 || ws_size < WS_END) { fprintf(stderr, "kernel_launch: built for 18 inputs and >= %zu bytes of workspace; got n_in %d, ws %zu; nothing launched\n", (size_t)WS_END, n_in, ws_size); grid = -1; return; }
        int dev = 0, cus = 0, per_cu = 0;
        if (hipGetDevice(&dev) != hipSuccess || hipDeviceGetAttribute(&cus, hipDeviceAttributeMultiprocessorCount, dev) != hipSuccess) { fprintf(stderr, "kernel_launch: hipGetDevice / hipDeviceGetAttribute failed\n"); grid = -1; return; }
        if (hipFuncSetAttribute((const void*)mk_fwd, hipFuncAttributeMaxDynamicSharedMemorySize, LDS_BYTES) != hipSuccess) { fprintf(stderr, "kernel_launch: hipFuncSetAttribute failed\n"); grid = -1; return; }
        if (hipOccupancyMaxActiveBlocksPerMultiprocessor(&per_cu, (const void*)mk_fwd, NWAVES * 64, LDS_BYTES) != hipSuccess || per_cu < 1)
            fprintf(stderr, "kernel_launch: note: the occupancy query reports %d workgroups per CU\n", per_cu);
        (void)hipGetLastError();
        grid = cus;
    }
    if (grid < 0) return;
    if (hipMemsetAsync((char*)d_ws + WS_CTL, 0, CTL_ZERO_BYTES, stream) != hipSuccess) { fprintf(stderr, "kernel_launch: hipMemsetAsync failed\n"); return; }
    Args a{};
    for (int i = 0; i < 18; ++i) a.in[i] = (const float*)d_in[i];
    a.out = (float*)d_out; a.ws = (unsigned char*)d_ws;
    for (int li = 0; li < N_LAUNCHES; ++li) {
        a.ph_lo = (N_LAUNCHES == 1) ? 0 : li; a.ph_hi = (N_LAUNCHES == 1) ? NPHASE : li + 1; a.li = li;
        hipLaunchKernelGGL(mk_fwd, dim3(grid), dim3(NWAVES * 64), LDS_BYTES, stream, a);
        const hipError_t le = hipPeekAtLastError();
        if (le != hipSuccess) { fprintf(stderr, "kernel_launch: launch %d failed: %s\n", li, hipGetErrorName(le)); break; }
    }
}
```

```cpp
#include <hip/hip_runtime.h>
#include <cstdio>
#include <cstdint>
namespace pg8 {
#define PG8_LAS __attribute__((address_space(3)))
typedef unsigned short bf16_t;
typedef short bf16x8 __attribute__((ext_vector_type(8)));
typedef float f32x4 __attribute__((ext_vector_type(4)));
typedef unsigned u32x4 __attribute__((ext_vector_type(4)));
constexpr int BM = 256, BK = 64, HALF = 128, HTB = HALF * BK * 2  , STAGE_BYTES = 8 * HTB, NXCD = 8, WGM = 8;

__host__ __device__ __forceinline__ int lds_byte(int r, int c) { const int st = (r >> 4) * 2 + (c >> 5), rr = r & 15, cc = c & 31, ob = rr * 64 + cc * 2; return st * 1024 + (ob ^ (((ob >> 9) & 1) << 5)); }
__host__ __device__ __forceinline__ void stage_rc(int b, int& R, int& C) { const int st = b / 1024, sb = b % 1024, swz = sb ^ (((sb >> 9) & 1) << 5); R = (st >> 1) * 16 + swz / 64; C = (st & 1) * 32 + (swz % 64) / 2; }
__host__ __device__ __forceinline__ int perm32(int rho) { const int n = rho >> 4, i = rho & 15; return 8 * (i >> 2) + 4 * n + (i & 3); }

struct Unit { int pm, pn; };
struct Gemm { const bf16_t* A; const bf16_t* Bt; int M, N, K; };

struct StaticOrder {
    int nM, nN, nwg, G, c;
    __host__ __device__ void init(int M, int N, int G_, int c_) { nM = M / BM; nN = N / BM; nwg = nM * nN; G = G_; c = c_; }
    __host__ __device__ bool next(int i, Unit& u) const {
        const long L = (long)i * G + c; if (L >= nwg) return false;
        int wgid = (int)L; { const int q = nwg / NXCD, r = nwg % NXCD, xcd = wgid % NXCD, off = wgid / NXCD; wgid = (xcd < r ? xcd * (q + 1) : r * (q + 1) + (xcd - r) * q) + off; }
        const int nig = WGM * nN, gid = wgid / nig, fm = gid * WGM, gsz = (nM - fm) < WGM ? (nM - fm) : WGM;
        u.pm = fm + ((wgid % nig) % gsz); u.pn = (wgid % nig) / gsz; return true;
    }
    __device__ __forceinline__ void a_ready(const Unit&) const {}
    __device__ __forceinline__ void done(const Unit&) const {}
};

__device__ __forceinline__ unsigned cvt_pk_bf16(float lo, float hi) { unsigned r; asm volatile("v_cvt_pk_bf16_f32 %0, %1, %2" : "=v"(r) : "v"(lo), "v"(hi)); return r; }
struct EpiF32 {
    static constexpr bool PERM = false, AFTER_DRAIN = false;
    float* C; int ldc;
    __device__ __forceinline__ void operator()(const f32x4 (&acc)[2][2][4][2], const Unit& u, int wr, int wc, int fr, int fq) const {
        const int row0 = u.pm * BM + wr * 64 + fr, col0 = u.pn * BM + wc * 32 + 4 * fq;
#pragma unroll
        for (int ai = 0; ai < 2; ++ai)
#pragma unroll
            for (int m = 0; m < 4; ++m) { float* rowp = C + (size_t)(row0 + ai * HALF + m * 16) * ldc + col0;
#pragma unroll
                for (int bj = 0; bj < 2; ++bj)
#pragma unroll
                    for (int n = 0; n < 2; ++n) *(f32x4*)(rowp + bj * HALF + n * 16) = acc[ai][bj][m][n]; }
    }
};
struct EpiBf16P {
    static constexpr bool PERM = true, AFTER_DRAIN = false;
    bf16_t* O; int ldc;
    __device__ __forceinline__ void operator()(const f32x4 (&acc)[2][2][4][2], const Unit& u, int wr, int wc, int fr, int fq) const {
        const int row0 = u.pm * BM + wr * 64 + fr, col0 = u.pn * BM + wc * 32 + 8 * fq;
#pragma unroll
        for (int ai = 0; ai < 2; ++ai)
#pragma unroll
            for (int m = 0; m < 4; ++m) { bf16_t* rowp = O + (size_t)(row0 + ai * HALF + m * 16) * ldc + col0;
#pragma unroll
                for (int bj = 0; bj < 2; ++bj) { const f32x4 v0 = acc[ai][bj][m][0], v1 = acc[ai][bj][m][1];
                    u32x4 w; w.x = cvt_pk_bf16(v0[0], v0[1]); w.y = cvt_pk_bf16(v0[2], v0[3]); w.z = cvt_pk_bf16(v1[0], v1[1]); w.w = cvt_pk_bf16(v1[2], v1[3]);
                    *(u32x4*)(rowp + bj * HALF) = w; } }
    }
};
__device__ __forceinline__ float silu_mul(float g, float u) { return g * __builtin_amdgcn_rcpf(1.0f + __builtin_amdgcn_exp2f(-1.4426950408889634f * g)) * u; }
struct EpiSwiglu {
    static constexpr bool PERM = true, AFTER_DRAIN = false;
    bf16_t* O; int ldc;
    __device__ __forceinline__ void operator()(const f32x4 (&acc)[2][2][4][2], const Unit& u, int wr, int wc, int fr, int fq) const {
        const int row0 = u.pm * BM + wr * 64 + fr, col0 = u.pn * HALF + wc * 32 + 8 * fq;
#pragma unroll
        for (int ai = 0; ai < 2; ++ai)
#pragma unroll
            for (int m = 0; m < 4; ++m) { bf16_t* rowp = O + (size_t)(row0 + ai * HALF + m * 16) * ldc + col0;
                const f32x4 g0 = acc[ai][0][m][0], g1 = acc[ai][0][m][1], u0 = acc[ai][1][m][0], u1 = acc[ai][1][m][1];
                u32x4 w; w.x = cvt_pk_bf16(silu_mul(g0[0], u0[0]), silu_mul(g0[1], u0[1])); w.y = cvt_pk_bf16(silu_mul(g0[2], u0[2]), silu_mul(g0[3], u0[3]));
                w.z = cvt_pk_bf16(silu_mul(g1[0], u1[0]), silu_mul(g1[1], u1[1])); w.w = cvt_pk_bf16(silu_mul(g1[2], u1[2]), silu_mul(g1[3], u1[3]));
                *(u32x4*)rowp = w; }
    }
};

template <class Epi, class Sched, bool ALIGN_EPI = false, bool SP2 = false>
__device__ __forceinline__ void gemm_phase(PG8_LAS unsigned char* lds, const Gemm g, const Sched& S, const Epi& E) {
    int tid_ = threadIdx.x; asm volatile("" : "+v"(tid_));
    const int tid = tid_, wid = __builtin_amdgcn_readfirstlane(tid >> 6), lane = tid & 63, wr = wid >> 2, wc = wid & 3, fr = lane & 15, fq = lane >> 4;
    const int K = g.K, nt = K / BK;
    unsigned voffA[2], voffB[2];
#pragma unroll
    for (int i = 0; i < 2; ++i) { int R, C; stage_rc(tid * 16 + i * 8192, R, C); const int Rb = Epi::PERM ? ((R & ~31) + perm32(R & 31)) : R;
        voffA[i] = (unsigned)(R * K + C) * 2u; voffB[i] = (unsigned)(Rb * K + C) * 2u; }
    const size_t kstep = (size_t)(BK * 2);
    const size_t hstep = (size_t)HALF * K * 2;
    const size_t tstep = 2 * hstep;
    const unsigned ldsw = (unsigned)wid * 1024u;
    const int aoff = lds_byte(wr * 64 + fr, fq * 8), boff = lds_byte(wc * 32 + fr, fq * 8);
#define PG8_SA(b, h) (((b) * 2 + (h)) * HTB)
#define PG8_SB(b, h) ((4 + (b) * 2 + (h)) * HTB)
#define PG8_STAGE(bufoff, gbase, voff) do { _Pragma("unroll") for (int _i = 0; _i < 2; ++_i) \
        __builtin_amdgcn_global_load_lds((const unsigned*)((const char*)(gbase) + (voff)[_i]), (PG8_LAS unsigned*)(lds + (bufoff) + ldsw + _i * 8192), 16, 0, 0); } while (0)
#define PG8_LDA(dst, b, h) do { _Pragma("unroll") for (int m = 0; m < 4; ++m) _Pragma("unroll") for (int k = 0; k < 2; ++k) dst[m][k] = *(const PG8_LAS bf16x8*)(lds + PG8_SA(b, h) + aoff + m * 2048 + k * 1024); } while (0)
#define PG8_LDB(dst, b, h) do { _Pragma("unroll") for (int n = 0; n < 2; ++n) _Pragma("unroll") for (int k = 0; k < 2; ++k) dst[n][k] = *(const PG8_LAS bf16x8*)(lds + PG8_SB(b, h) + boff + n * 2048 + k * 1024); } while (0)
#define PG8_MMA(ai, bj, At, Bt) do { __builtin_amdgcn_s_setprio(1); _Pragma("unroll") for (int m = 0; m < 4; ++m) _Pragma("unroll") for (int n = 0; n < 2; ++n) _Pragma("unroll") for (int k = 0; k < 2; ++k) \
        acc[ai][bj][m][n] = __builtin_amdgcn_mfma_f32_16x16x32_bf16(Bt[n][k], At[m][k], acc[ai][bj][m][n], 0, 0, 0); __builtin_amdgcn_s_setprio(0); } while (0)
#define PG8_WAIT_V(n) asm volatile("s_waitcnt vmcnt(" #n ")" ::: "memory")
#define PG8_WAIT_L(n) asm volatile("s_waitcnt lgkmcnt(" #n ")" ::: "memory")
#define PG8_BAR __builtin_amdgcn_s_barrier()
#define PG8_SCHED __builtin_amdgcn_sched_barrier(0)
    Unit cur, nxt; int ui = 0;
    if (!S.next(0, cur)) return;
    f32x4 acc[2][2][4][2];
#pragma unroll
    for (int a = 0; a < 2; ++a)
#pragma unroll
        for (int b = 0; b < 2; ++b)
#pragma unroll
            for (int m = 0; m < 4; ++m)
#pragma unroll
                for (int n = 0; n < 2; ++n) acc[a][b][m][n] = (f32x4){0.f, 0.f, 0.f, 0.f};
    bf16x8 At[4][2], B0[2][2], B1[2][2];
    const char* cA = (const char*)g.A + (size_t)cur.pm * tstep; const char* cB = (const char*)g.Bt + (size_t)cur.pn * tstep;
    S.a_ready(cur);
    if constexpr (SP2) {
        PG8_STAGE(PG8_SB(0, 0), cB, voffB); PG8_STAGE(PG8_SB(0, 1), cB + hstep, voffB); PG8_STAGE(PG8_SA(0, 0), cA, voffA); PG8_STAGE(PG8_SA(0, 1), cA + hstep, voffA);
        if (wr == 1) PG8_BAR;
        PG8_WAIT_V(2); PG8_BAR;
        PG8_STAGE(PG8_SB(1, 0), cB + kstep, voffB); PG8_STAGE(PG8_SA(1, 0), cA + kstep, voffA); PG8_STAGE(PG8_SB(1, 1), cB + hstep + kstep, voffB);
        PG8_WAIT_V(6); PG8_BAR;
    } else {
        PG8_STAGE(PG8_SB(0, 0), cB, voffB); PG8_STAGE(PG8_SA(0, 0), cA, voffA); PG8_STAGE(PG8_SB(0, 1), cB + hstep, voffB); PG8_STAGE(PG8_SA(0, 1), cA + hstep, voffA);
        if (wr == 1) PG8_BAR;
        PG8_WAIT_V(4); PG8_BAR;
        PG8_STAGE(PG8_SB(1, 0), cB + kstep, voffB); PG8_STAGE(PG8_SA(1, 0), cA + kstep, voffA); PG8_STAGE(PG8_SB(1, 1), cB + hstep + kstep, voffB);
        PG8_WAIT_V(6); PG8_BAR;
    }
    for (;;) {
        const bool has_next = S.next(ui + 1, nxt);
        const char* nA = has_next ? (const char*)g.A + (size_t)nxt.pm * tstep : cA; const char* nB = has_next ? (const char*)g.Bt + (size_t)nxt.pn * tstep : cB;
        for (int t = 0; t < nt; t += 2) {
            const bool last = (t == nt - 2);
            const char* a1 = cA + (size_t)(t + 1) * kstep;
            const char* a2 = last ? nA : cA + (size_t)(t + 2) * kstep; const char* b2 = last ? nB : cB + (size_t)(t + 2) * kstep;
            const char* a3 = a2 + kstep; const char* b3 = b2 + kstep;
            if (last && has_next) S.a_ready(nxt);
            if constexpr (SP2) {
            PG8_LDB(B0, 0, 0); PG8_LDB(B1, 0, 1); PG8_SCHED; PG8_LDA(At, 0, 0); PG8_STAGE(PG8_SA(1, 1), a1 + hstep, voffA);
            PG8_WAIT_V(8); PG8_WAIT_L(0); PG8_BAR; PG8_MMA(0, 0, At, B0); PG8_MMA(0, 1, At, B1); PG8_BAR; PG8_SCHED;
            PG8_LDA(At, 0, 1); PG8_STAGE(PG8_SB(0, 0), b2, voffB); PG8_STAGE(PG8_SB(0, 1), b2 + hstep, voffB); PG8_STAGE(PG8_SA(0, 0), a2, voffA);
            PG8_WAIT_V(8); PG8_WAIT_L(0); PG8_BAR; PG8_MMA(1, 0, At, B0); PG8_MMA(1, 1, At, B1); PG8_BAR; PG8_SCHED;
            PG8_LDB(B0, 1, 0); PG8_LDB(B1, 1, 1); PG8_SCHED; PG8_LDA(At, 1, 0); PG8_STAGE(PG8_SA(0, 1), a2 + hstep, voffA);
            PG8_WAIT_V(8); PG8_WAIT_L(0); PG8_BAR; PG8_MMA(0, 0, At, B0); PG8_MMA(0, 1, At, B1); PG8_BAR; PG8_SCHED;
            PG8_LDA(At, 1, 1); PG8_STAGE(PG8_SB(1, 0), b3, voffB); PG8_STAGE(PG8_SB(1, 1), b3 + hstep, voffB); PG8_STAGE(PG8_SA(1, 0), a3, voffA);
            PG8_WAIT_V(8); PG8_WAIT_L(0); PG8_BAR; PG8_MMA(1, 0, At, B0); PG8_MMA(1, 1, At, B1); PG8_BAR; PG8_SCHED;
            } else {
            PG8_LDB(B0, 0, 0); PG8_SCHED; PG8_LDA(At, 0, 0); PG8_STAGE(PG8_SA(1, 1), a1 + hstep, voffA);
            PG8_WAIT_L(8); PG8_BAR; PG8_WAIT_L(0); PG8_MMA(0, 0, At, B0); PG8_BAR; PG8_SCHED;
            PG8_LDB(B1, 0, 1); PG8_STAGE(PG8_SB(0, 0), b2, voffB);
            PG8_BAR; PG8_WAIT_L(0); PG8_MMA(0, 1, At, B1); PG8_BAR;
            PG8_LDA(At, 0, 1); PG8_STAGE(PG8_SA(0, 0), a2, voffA);
            PG8_BAR; PG8_WAIT_L(0); PG8_MMA(1, 0, At, B0); PG8_BAR; PG8_SCHED;
            PG8_STAGE(PG8_SB(0, 1), b2 + hstep, voffB);
            PG8_WAIT_V(6); PG8_BAR; PG8_MMA(1, 1, At, B1); PG8_BAR;
            PG8_LDB(B0, 1, 0); PG8_SCHED; PG8_LDA(At, 1, 0); PG8_STAGE(PG8_SA(0, 1), a2 + hstep, voffA);
            PG8_WAIT_L(8); PG8_BAR; PG8_WAIT_L(0); PG8_MMA(0, 0, At, B0); PG8_BAR; PG8_SCHED;
            PG8_LDB(B1, 1, 1); PG8_STAGE(PG8_SB(1, 0), b3, voffB);
            PG8_BAR; PG8_WAIT_L(0); PG8_MMA(0, 1, At, B1); PG8_BAR;
            PG8_LDA(At, 1, 1); PG8_STAGE(PG8_SA(1, 0), a3, voffA);
            PG8_BAR; PG8_WAIT_L(0); PG8_MMA(1, 0, At, B0); PG8_BAR; PG8_SCHED;
            PG8_STAGE(PG8_SB(1, 1), b3 + hstep, voffB);
            PG8_WAIT_V(6); PG8_BAR; PG8_MMA(1, 1, At, B1); PG8_BAR;
            }
        }
        if constexpr (ALIGN_EPI) { if (wr == 0) PG8_BAR; }
        if constexpr (!Epi::AFTER_DRAIN) { E(acc, cur, wr, wc, fr, fq); S.done(cur); }
        if (!has_next) break;
#pragma unroll
        for (int a = 0; a < 2; ++a)
#pragma unroll
            for (int b = 0; b < 2; ++b)
#pragma unroll
                for (int m = 0; m < 4; ++m)
#pragma unroll
                    for (int n = 0; n < 2; ++n) acc[a][b][m][n] = (f32x4){0.f, 0.f, 0.f, 0.f};
        cur = nxt; cA = nA; cB = nB; ++ui;
        if constexpr (ALIGN_EPI) { if (wr == 1) PG8_BAR; }
    }
    PG8_WAIT_V(0);
    if constexpr (!ALIGN_EPI) { if (wr == 0) PG8_BAR; }
    PG8_BAR;
    if constexpr (Epi::AFTER_DRAIN) { E.fused(acc, cur, wr, wc, fr, fq, lds, wid, lane); S.done(cur); }
#undef PG8_SA
#undef PG8_SB
#undef PG8_STAGE
#undef PG8_LDA
#undef PG8_LDB
#undef PG8_MMA
#undef PG8_WAIT_V
#undef PG8_WAIT_L
#undef PG8_BAR
#undef PG8_SCHED
}
}

#define GAS __attribute__((address_space(1)))
#define LAS __attribute__((address_space(3)))
typedef unsigned short bf16;
typedef unsigned v4u __attribute__((ext_vector_type(4)));
typedef float f32x4 __attribute__((ext_vector_type(4)));
typedef short bf16x8 __attribute__((ext_vector_type(8)));
typedef GAS unsigned gu32;
typedef GAS unsigned long long gu64;
#define RLX_AGENT __ATOMIC_RELAXED, __HIP_MEMORY_SCOPE_AGENT
#define LDS_WAIT() asm volatile("s_waitcnt lgkmcnt(0)" ::: "memory")
#define VM_WAIT() asm volatile("s_waitcnt vmcnt(0)" ::: "memory")
__device__ __forceinline__ unsigned long long rt() { return __builtin_amdgcn_s_memrealtime(); }
__device__ __forceinline__ unsigned f2bf(float f) { unsigned u = __builtin_bit_cast(unsigned, f); return (u + 0x7fffu + ((u >> 16) & 1u)) >> 16; }
typedef float f32x2_t __attribute__((ext_vector_type(2))); typedef __bf16 bf16x2_t __attribute__((ext_vector_type(2)));
__device__ __forceinline__ unsigned pk2(float lo, float hi) { f32x2_t v = {lo, hi}; bf16x2_t b = __builtin_convertvector(v, bf16x2_t); return __builtin_bit_cast(unsigned, b); }

#define XB_TMO      128
#define XB_XCNT(j)  (256  + 64 * (j))
#define XB_XSUB(j)  (1280 + 64 * (j))
#define XB_XGEN(j)  (2304 + 64 * (j))
#define XB_TOP      3328
#define XB_TOPGEN   3392
#define XCD_BAR_WORDS 3456
#define XB_SPIN_CAP (1u << 18)

__device__ __forceinline__ unsigned xb_ld(unsigned* p)              { return __hip_atomic_load(p, __ATOMIC_RELAXED, __HIP_MEMORY_SCOPE_AGENT); }
__device__ __forceinline__ unsigned xb_add(unsigned* p, unsigned v) { return __hip_atomic_fetch_add(p, v, __ATOMIC_RELAXED, __HIP_MEMORY_SCOPE_AGENT); }
__device__ __forceinline__ unsigned xb_xcc_id() { return (unsigned)__builtin_amdgcn_s_getreg((3 << 11) | 20) & 0xFu; }
#define XB_SPIN(cond, bar) do { unsigned _sp = 0; while (cond) { __builtin_amdgcn_s_sleep(1); \
    if ((++_sp & 255u) == 0u) { if (xb_ld(&(bar)[XB_TMO])) break; if (_sp > XB_SPIN_CAP) { atomicAdd(&(bar)[XB_TMO], 1u); break; } } } } while (0)

struct XcdBarrier {
    unsigned* bar; unsigned x;
    volatile LAS unsigned* st;
};

__device__ __forceinline__ XcdBarrier xcd_barrier_post(unsigned* bar, volatile LAS unsigned* st) {
    XcdBarrier b; b.bar = bar; b.x = xb_xcc_id(); b.st = st;
    if (threadIdx.x == 0) (void)xb_add(&bar[XB_XCNT(b.x)], 1u);
    return b;
}
__device__ __forceinline__ void xcd_barrier_complete(unsigned* bar, unsigned x, unsigned& nloc, unsigned& nx) {
    const unsigned G = gridDim.x * gridDim.y * gridDim.z;
    unsigned sum, cnt, mine, sp = 0u;
    for (;;) {
        sum = 0u; cnt = 0u; mine = 0u;
#pragma unroll
        for (unsigned j = 0; j < 16; ++j) { const unsigned c = xb_ld(&bar[XB_XCNT(j)]); sum += c; cnt += (c > 0u) ? 1u : 0u; mine = (j == x) ? c : mine; }
        if (sum == G) break;
        __builtin_amdgcn_s_sleep(1);
        if ((++sp & 255u) == 0u) { if (xb_ld(&bar[XB_TMO])) break; if (sp > XB_SPIN_CAP) { atomicAdd(&bar[XB_TMO], 1u); break; } }
    }
    nloc = mine > 0u ? mine : 1u; nx = cnt > 0u ? cnt : 1u;
}

__device__ __forceinline__ void xcd_barrier(const XcdBarrier& b) {
    asm volatile("s_waitcnt vmcnt(0)" ::: "memory");
    __syncthreads();
    if (threadIdx.x == 0) {
        unsigned* bar = b.bar;
        __builtin_amdgcn_s_waitcnt(0);
        unsigned nloc = b.st[0], nx = b.st[1];
        if (nloc == 0u) { xcd_barrier_complete(bar, b.x, nloc, nx); b.st[0] = nloc; b.st[1] = nx; }
        const unsigned old = xb_add(&bar[XB_XSUB(b.x)], 1u);
        const unsigned gen = old / nloc;
        if (old + 1u == (gen + 1u) * nloc) {
            __builtin_amdgcn_fence(__ATOMIC_RELEASE, "agent");
            asm volatile("s_waitcnt vmcnt(0)" ::: "memory");
            const unsigned og = xb_add(&bar[XB_TOP], 1u);
            const unsigned tg = og / nx;
            if (og + 1u == (tg + 1u) * nx) xb_add(&bar[XB_TOPGEN], 1u);
            else XB_SPIN(xb_ld(&bar[XB_TOPGEN]) == tg, bar);
            __builtin_amdgcn_fence(__ATOMIC_ACQUIRE, "agent");
            xb_add(&bar[XB_XGEN(b.x)], 1u);
            asm volatile("s_waitcnt vmcnt(0)" ::: "memory");
        } else {
            XB_SPIN(xb_ld(&bar[XB_XGEN(b.x)]) == gen, bar);
            __builtin_amdgcn_fence(__ATOMIC_ACQUIRE, "agent");
            asm volatile("s_waitcnt vmcnt(0)" ::: "memory");
        }
    }
    __syncthreads();
}

constexpr int NWAVES = 8;
#ifndef MK_N_LAUNCHES
#define MK_N_LAUNCHES 1
#endif
#ifndef MK_PROBE
#define MK_PROBE 0
#endif
#ifndef MK_NAIVE_MIX
#define MK_NAIVE_MIX 0
#endif

constexpr int D = 1024, DEPTH = 4, DFF = 2816, NIN = 1536, NMOD = 9;
constexpr int M_CTX = 32 * 256, M_LAT = 2 * 2048, M = M_CTX + M_LAT;
constexpr int SEQ_C = 256, SEQ_L = 2048, PAST = 512;
constexpr float EPS = 1e-6f;
constexpr int NPHASE = 2 + 10 * DEPTH;
constexpr int N_LAUNCHES = (MK_N_LAUNCHES == 1) ? 1 : NPHASE;

constexpr size_t MiB = 1u << 20;
constexpr size_t WS_CTL = 0, CTL_ZERO_BYTES = 1 * MiB;
constexpr size_t WS_MOD = 1 * MiB;
constexpr size_t WS_ROPE = 2 * MiB;
constexpr size_t WS_W1T = 4 * MiB;
constexpr size_t WS_W2T = 92 * MiB;
constexpr size_t WS_WIN = 136 * MiB;
constexpr size_t WS_WOUT = 148 * MiB;
constexpr size_t WS_H = 156 * MiB;
constexpr size_t WS_A = 180 * MiB;
constexpr size_t WS_O = 246 * MiB;
constexpr size_t WS_QKV = 294 * MiB;
constexpr size_t WS_MIX = 330 * MiB;
constexpr size_t WS_END = 354 * MiB;
constexpr int CW_BAR = 4096;

constexpr int RING_OFF = 0, RING_BYTES = 131072;
constexpr int LDSCTL_OFF = RING_BYTES, MISC_OFF = LDSCTL_OFF + 320;
constexpr int LDS_BYTES = 147456;

__device__ __forceinline__ float bf2f(unsigned short v) { return __uint_as_float((unsigned)v << 16); }
__device__ __forceinline__ float wave_sum(float v) {
#pragma unroll
    for (int o = 1; o < 64; o <<= 1) v += __shfl_xor(v, o);
    return v;
}
__device__ __forceinline__ float wave_max(float v) {
#pragma unroll
    for (int o = 1; o < 64; o <<= 1) v = fmaxf(v, __shfl_xor(v, o));
    return v;
}

struct Frame {
    LAS unsigned char* lds;
    int tid, lane, wave, vcu, G;
    unsigned char* ws; unsigned char* ws0; float* out;
};
__device__ __forceinline__ void frame_refresh(Frame& F) {
    int t_ = threadIdx.x, b_ = blockIdx.x; asm volatile("" : "+v"(t_)); asm volatile("" : "+s"(b_));
    F.tid = t_; F.lane = t_ & 63; F.wave = __builtin_amdgcn_readfirstlane(t_ >> 6);
    F.G = gridDim.x; F.vcu = (F.G % 8 == 0) ? (b_ % 8) * (F.G / 8) + b_ / 8 : b_;
    unsigned char* w_ = F.ws0; asm volatile("" : "+s"(w_)); F.ws = w_;
}
typedef __attribute__((address_space(4))) const unsigned char* kargp_t;
template <int I> __device__ __forceinline__ const float* inp() {
    kargp_t kp = (kargp_t)__builtin_amdgcn_kernarg_segment_ptr(); unsigned long long v;
    asm volatile("s_load_dwordx2 %0, %1, %2\n\ts_waitcnt lgkmcnt(0)" : "=s"(v) : "s"(kp), "i"(8 * I) : "memory");
    return (const float*)v;
}
enum { I_XP = 0, I_XS, I_CK, I_CV, I_C, I_CCTX, I_WMOD, I_BMOD, I_NORMW, I_WIN, I_WOUT, I_SINK, I_WSP, I_BSP, I_WPOOL, I_PSCALE, I_W1, I_W2 };
#define P_MOD(F)  ((float*)((F).ws + WS_MOD))
#define P_ROPEC(F) ((float*)((F).ws + WS_ROPE))
#define P_ROPES(F) ((float*)((F).ws + WS_ROPE) + SEQ_L * 32)
#define P_O(F)    ((float*)((F).ws + WS_O))
#define P_W1T(F)  ((bf16*)((F).ws + WS_W1T))
#define P_W2T(F)  ((bf16*)((F).ws + WS_W2T))
#define P_WIN(F)  ((bf16*)((F).ws + WS_WIN))
#define P_WOUT(F) ((bf16*)((F).ws + WS_WOUT))
#define P_H(F)    ((bf16*)((F).ws + WS_H))
#define P_A(F)    ((bf16*)((F).ws + WS_A))
#define P_QKV(F)  ((bf16*)((F).ws + WS_QKV))
#define P_MIX(F)  ((bf16*)((F).ws + WS_MIX))

__device__ const double ROPE_INV[16] = {1.0, 0.5623413251903491, 0.31622776601683794, 0.1778279410038923, 0.1, 0.05623413251903491, 0.03162277660168379, 0.01778279410038923,
                                        0.01, 0.005623413251903491, 0.0031622776601683794, 0.0017782794100389228, 0.001, 0.0005623413251903491, 0.00031622776601683794, 0.00017782794100389227};
__device__ __forceinline__ void sincos_d(double x, double& s, double& c) {
    const double kd = __builtin_rint(x * 0.63661977236758134308); const int k = (int)kd;
    double r = __builtin_fma(-kd, 1.57079632679489655800e+00, x); r = __builtin_fma(-kd, 6.12323399573676603587e-17, r);
    const double r2 = r * r;
    const double sp = r * (1.0 + r2 * (-1.0 / 6 + r2 * (1.0 / 120 + r2 * (-1.0 / 5040 + r2 * (1.0 / 362880 + r2 * (-1.0 / 39916800 + r2 * (1.0 / 6227020800.0)))))));
    const double cp = 1.0 + r2 * (-0.5 + r2 * (1.0 / 24 + r2 * (-1.0 / 720 + r2 * (1.0 / 40320 + r2 * (-1.0 / 3628800 + r2 * (1.0 / 479001600 + r2 * (-1.0 / 87178291200.0)))))));
    switch (k & 3) { case 0: s = sp; c = cp; break; case 1: s = cp; c = -sp; break; case 2: s = -sp; c = -cp; break; default: s = -cp; c = sp; break; }
}
__device__ __forceinline__ void phase_mod(Frame& F) {
    frame_refresh(F);
    const float* c_ctx = inp<I_CCTX>(); const float* cvec = inp<I_C>(); const float* w_mod = inp<I_WMOD>(); const float* b_mod = inp<I_BMOD>();
    float* modp = P_MOD(F); float* ropec = P_ROPEC(F); float* ropes = P_ROPES(F);
    LAS float* sil = (LAS float*)F.lds;
    LAS float* part = (LAS float*)(F.lds + 16384);
    for (int i = F.tid; i < 3 * D; i += NWAVES * 64) { const int b = i >> 10, k = i & 1023; const float cv = (b == 0) ? c_ctx[k] : cvec[(b - 1) * D + k]; sil[i] = cv / (1.0f + expf(-cv)); }
    __syncthreads();
    const int ct = F.tid & 15, kg = F.tid >> 4;
    for (int unit = F.vcu; unit < DEPTH * 144; unit += F.G) {
        const int l = unit / 144, cb = unit % 144;
        const float* wp = w_mod + ((size_t)l * D + kg * 32) * (NMOD * D) + cb * 64 + ct * 4;
        f32x4 a0 = {0.f, 0.f, 0.f, 0.f}, a1 = a0, a2 = a0;
#pragma unroll 8
        for (int kk = 0; kk < 32; ++kk) { const f32x4 w = *(const f32x4*)(wp + (size_t)kk * (NMOD * D)); const int k = kg * 32 + kk;
            a0 += sil[k] * w; a1 += sil[D + k] * w; a2 += sil[2 * D + k] * w; }
        *(LAS f32x4*)(part + (kg * 3 + 0) * 64 + ct * 4) = a0; *(LAS f32x4*)(part + (kg * 3 + 1) * 64 + ct * 4) = a1; *(LAS f32x4*)(part + (kg * 3 + 2) * 64 + ct * 4) = a2;
        __syncthreads();
        if (F.tid < 192) { const int b = F.tid >> 6, col = F.tid & 63; float s = 0.f;
#pragma unroll 8
            for (int g = 0; g < 32; ++g) s += part[(g * 3 + b) * 64 + col];
            modp[((size_t)l * 3 + b) * (NMOD * D) + cb * 64 + col] = s + b_mod[(size_t)l * (NMOD * D) + cb * 64 + col]; }
        __syncthreads();
    }
    for (int e = F.vcu * (NWAVES * 64) + F.tid; e < SEQ_L * 32; e += F.G * NWAVES * 64) {
        const int t = e >> 5, ai = e & 31; const double pos = (ai < 16) ? (double)(t >> 6) : (double)(t & 63);
        double s, c; sincos_d(pos * ROPE_INV[ai & 15], s, c); ropec[e] = (float)c; ropes[e] = (float)s;
    }
}

constexpr int TI_PITCH = 136;
__device__ __forceinline__ void transpose_item(const GAS float* W, int K, int N, GAS bf16* WT, int k0, int n0, int drow0, LAS unsigned char* scr, int lane) {
    const int kr = lane >> 4, nc = lane & 15;
    f32x4 v[16];
#pragma unroll
    for (int i = 0; i < 16; ++i) v[i] = *(const GAS f32x4*)(W + (size_t)(k0 + 4 * i + kr) * N + n0 + 4 * nc);
#pragma unroll
    for (int i = 0; i < 16; ++i) { LAS unsigned short* p = (LAS unsigned short*)(scr + (4 * nc) * TI_PITCH + 2 * (4 * i + kr));
        p[0] = (unsigned short)f2bf(v[i].x); p[TI_PITCH / 2] = (unsigned short)f2bf(v[i].y); p[2 * (TI_PITCH / 2)] = (unsigned short)f2bf(v[i].z); p[3 * (TI_PITCH / 2)] = (unsigned short)f2bf(v[i].w); }
    LDS_WAIT(); asm volatile("" ::: "memory");
    const int c = lane & 7;
#pragma unroll
    for (int j = 0; j < 8; ++j) { const int n = (lane >> 3) + 8 * j;
        const unsigned long long lo = *(const LAS unsigned long long*)(scr + n * TI_PITCH + 16 * c), hi = *(const LAS unsigned long long*)(scr + n * TI_PITCH + 16 * c + 8);
        v4u o; o.x = (unsigned)lo; o.y = (unsigned)(lo >> 32); o.z = (unsigned)hi; o.w = (unsigned)(hi >> 32);
        *(GAS v4u*)(WT + (size_t)(drow0 + n) * K + k0 + 8 * c) = o; }
    LDS_WAIT(); asm volatile("" ::: "memory");
}
__device__ __forceinline__ int mod_row(int m) { return m < M_CTX ? 0 : 1 + ((m - M_CTX) >> 11); }
__device__ __forceinline__ void prenorm_row(Frame& F, const f32x4 (&v)[4], const float* w_pre, const float* shift, const float* scale, bf16* hrow) {
    float ss = 0.f;
#pragma unroll
    for (int j = 0; j < 4; ++j) ss += (v[j].x * v[j].x + v[j].y * v[j].y) + (v[j].z * v[j].z + v[j].w * v[j].w);
    const float rstd = 1.0f / sqrtf(wave_sum(ss) * (1.0f / D) + EPS);
    GAS unsigned long long* o8 = (GAS unsigned long long*)hrow + F.lane;
#pragma unroll
    for (int j = 0; j < 4; ++j) { const int col = 4 * F.lane + 256 * j; const f32x4 w = *(const f32x4*)(w_pre + col), sh = *(const f32x4*)(shift + col), sc = *(const f32x4*)(scale + col);
        const f32x4 h = (v[j] * rstd * w) * (1.0f + sc) + sh;
        o8[64 * j] = (unsigned long long)pk2(h.x, h.y) | ((unsigned long long)pk2(h.z, h.w) << 32); }
}
__device__ __forceinline__ void phase_pre(Frame& F) {
    frame_refresh(F);
    const GAS float* ffn_w1 = (const GAS float*)inp<I_W1>(); const GAS float* ffn_w2 = (const GAS float*)inp<I_W2>(); const GAS float* w_in = (const GAS float*)inp<I_WIN>(); const GAS float* w_out = (const GAS float*)inp<I_WOUT>();
    GAS bf16* W1T = (GAS bf16*)P_W1T(F); GAS bf16* W2T = (GAS bf16*)P_W2T(F); GAS bf16* WINp = (GAS bf16*)P_WIN(F); GAS bf16* WOUTp = (GAS bf16*)P_WOUT(F);
    LAS unsigned char* scr = F.lds + RING_OFF + F.wave * 16384;
    const int gw = F.vcu * NWAVES + F.wave, NGW = F.G * NWAVES;
    constexpr int I_W1 = 16 * 88, I_W2 = 44 * 16, I_IN = 16 * 24, I_OUT = 16 * 16, I_LAYER = 2 * I_W1 + 2 * I_W2 + I_IN + I_OUT;
    for (int it = gw; it < DEPTH * I_LAYER; it += NGW) {
        const int l = it / I_LAYER; int r = it % I_LAYER;
        if (r < 2 * I_W1) { const int f = r / I_W1; r %= I_W1; const int kb = r / 88, nb = r % 88, n0 = 64 * nb;
            const int nn = n0 < DFF ? n0 : n0 - DFF, drow0 = (nn >> 7) * 256 + (n0 < DFF ? 0 : 128) + (nn & 127);
            transpose_item(ffn_w1 + (size_t)(l * 2 + f) * D * (2 * DFF), D, 2 * DFF, W1T + (size_t)(l * 2 + f) * (2 * DFF) * D, 64 * kb, n0, drow0, scr, F.lane); continue; }
        r -= 2 * I_W1;
        if (r < 2 * I_W2) { const int f = r / I_W2; r %= I_W2; const int kb = r / 16, nb = r % 16;
            transpose_item(ffn_w2 + (size_t)(l * 2 + f) * DFF * D, DFF, D, W2T + (size_t)(l * 2 + f) * D * DFF, 64 * kb, 64 * nb, 64 * nb, scr, F.lane); continue; }
        r -= 2 * I_W2;
        if (r < I_IN) { const int kb = r / 24, nb = r % 24;
            transpose_item(w_in + (size_t)l * D * NIN, D, NIN, WINp + (size_t)l * NIN * D, 64 * kb, 64 * nb, 64 * nb, scr, F.lane); continue; }
        r -= I_IN;
        { const int kb = r / 16, nb = r % 16;
            transpose_item(w_out + (size_t)l * D * D, D, D, WOUTp + (size_t)l * D * D, 64 * kb, 64 * nb, 64 * nb, scr, F.lane); }
    }
    const float* x_prompt = inp<I_XP>(); const float* x_sample = inp<I_XS>(); const float* norm_w = inp<I_NORMW>(); const float* modp = P_MOD(F); bf16* Hp = P_H(F);
    for (int m = gw; m < M; m += NGW) {
        const float* xin = m < M_CTX ? x_prompt + (size_t)m * D : x_sample + (size_t)(m - M_CTX) * D;
        const GAS f32x4* xr = (const GAS f32x4*)xin + F.lane; GAS f32x4* xo = (GAS f32x4*)(F.out + (size_t)m * D) + F.lane;
        f32x4 v[4];
#pragma unroll
        for (int j = 0; j < 4; ++j) { v[j] = xr[64 * j]; xo[64 * j] = v[j]; }
        const float* md = modp + (size_t)mod_row(m) * (NMOD * D);
        prenorm_row(F, v, norm_w, md, md + D, Hp + (size_t)m * D);
    }
}

__device__ __forceinline__ void phase_norm(Frame& F, int l, int s) {
    frame_refresh(F);
    const float* norm_w = inp<I_NORMW>(); const float* modp = P_MOD(F); const float* Op = P_O(F); bf16* Hp = P_H(F);
    const int gw = F.vcu * NWAVES + F.wave, NGW = F.G * NWAVES;
    const int jpost = (s == 2) ? 1 : (s == 6) ? 3 : 5, jgate = (s == 2) ? 2 : (s == 6) ? 5 : 8;
    const float gs = (s == 6) ? 1.0f : 0.5f;
    const bool has_next = !(s == 9 && l == DEPTH - 1);
    const int ln = (s == 9) ? l + 1 : l, jpre = (s == 2) ? 2 : (s == 6) ? 4 : 0, jshift = (s == 2) ? 3 : (s == 6) ? 6 : 0;
    const float* w_post = norm_w + ((size_t)l * 6 + jpost) * D;
    for (int m = gw; m < M; m += NGW) {
        const int mr = mod_row(m);
        const float* gate = modp + ((size_t)(l * 3 + mr) * NMOD + jgate) * D;
        const GAS f32x4* orow = (const GAS f32x4*)(Op + (size_t)m * D) + F.lane; GAS f32x4* xrow = (GAS f32x4*)(F.out + (size_t)m * D) + F.lane;
        f32x4 o[4], v[4]; float ss = 0.f;
#pragma unroll
        for (int j = 0; j < 4; ++j) { o[j] = orow[64 * j]; v[j] = xrow[64 * j]; ss += (o[j].x * o[j].x + o[j].y * o[j].y) + (o[j].z * o[j].z + o[j].w * o[j].w); }
        const float rstd = 1.0f / sqrtf(wave_sum(ss) * (1.0f / D) + EPS);
#pragma unroll
        for (int j = 0; j < 4; ++j) { const int col = 4 * F.lane + 256 * j; const f32x4 w = *(const f32x4*)(w_post + col), g = *(const f32x4*)(gate + col);
            v[j] = v[j] + (gs * g) * (o[j] * rstd * w); xrow[64 * j] = v[j]; }
        if (has_next) {
            const float* mdn = modp + ((size_t)(ln * 3 + mr) * NMOD + jshift) * D;
            prenorm_row(F, v, norm_w + ((size_t)ln * 6 + jpre) * D, mdn, mdn + D, Hp + (size_t)m * D);
        }
    }
}

__device__ __forceinline__ void load8bf(const bf16* p, float (&f)[8]) {
    const v4u r = *(const v4u*)p;
    f[0] = __uint_as_float(r.x << 16); f[1] = __uint_as_float(r.x & 0xffff0000u); f[2] = __uint_as_float(r.y << 16); f[3] = __uint_as_float(r.y & 0xffff0000u);
    f[4] = __uint_as_float(r.z << 16); f[5] = __uint_as_float(r.z & 0xffff0000u); f[6] = __uint_as_float(r.w << 16); f[7] = __uint_as_float(r.w & 0xffff0000u);
}
__device__ __forceinline__ void mix_row_naive(Frame& F, int l, int m) {
    const int lane = F.lane;
    const float* cache_k = inp<I_CK>(); const float* cache_v = inp<I_CV>(); const float* attn_sink = inp<I_SINK>(); const float* w_spatial = inp<I_WSP>(); const float* b_spatial = inp<I_BSP>();
    const float* w_pool = inp<I_WPOOL>(); const float* pool_scale = inp<I_PSCALE>(); const float* ropec = P_ROPEC(F); const float* ropes = P_ROPES(F); const bf16* QKV = P_QKV(F); bf16* MIX = P_MIX(F);
    LAS float* qs = (LAS float*)(F.lds + F.wave * 4096); LAS float* sc = qs + 64;
    const bool lat = m >= M_CTX;
    int bl = 0, t, seq0, S;
    if (!lat) { t = m & 255; seq0 = m & ~255; S = SEQ_C; } else { const int r = m - M_CTX; bl = r >> 11; t = r & 2047; seq0 = M_CTX + (bl << 11); S = SEQ_L; }
    const bf16* qrow = QKV + (size_t)m * NIN;
    for (int hq = 0; hq < 8; ++hq) {
        const int kv = hq >> 2;
        float qv = bf2f(qrow[hq * 64 + lane]);
        if (lat) { const float pv = __shfl_xor(qv, 16); const int ai = (lane & 15) + ((lane >> 5) << 4); const float cs = ropec[t * 32 + ai], sn = ropes[t * 32 + ai];
            qv = (lane & 16) ? qv * cs + pv * sn : qv * cs - pv * sn; }
        qs[lane] = qv;
        LDS_WAIT(); asm volatile("" ::: "memory");
        int j0 = 0, nband = 0, nkeys = SEQ_C;
        if (lat) { j0 = t - 128 < 0 ? 0 : t - 128; const int j1 = t + 128 > SEQ_L - 1 ? SEQ_L - 1 : t + 128; nband = j1 - j0 + 1; nkeys = nband + PAST; }
        float mx = -3.0e38f;
        for (int idx = lane; idx < nkeys; idx += 64) {
            float dot = 0.f;
            if (!lat) {
                const bf16* kp = QKV + (size_t)(seq0 + idx) * NIN + 512 + kv * 64;
#pragma unroll
                for (int c8 = 0; c8 < 8; ++c8) { float kf[8]; load8bf(kp + 8 * c8, kf);
#pragma unroll
                    for (int e = 0; e < 8; ++e) dot += qs[8 * c8 + e] * kf[e]; }
            } else if (idx < nband) {
                const int kt = j0 + idx; const bf16* kp = QKV + (size_t)(seq0 + kt) * NIN + 512 + kv * 64;
                float kf[64];
#pragma unroll
                for (int c8 = 0; c8 < 8; ++c8) { float t8[8]; load8bf(kp + 8 * c8, t8);
#pragma unroll
                    for (int e = 0; e < 8; ++e) kf[8 * c8 + e] = t8[e]; }
#pragma unroll
                for (int a = 0; a < 2; ++a)
#pragma unroll
                    for (int d = 0; d < 16; ++d) { const float cs = ropec[kt * 32 + a * 16 + d], sn = ropes[kt * 32 + a * 16 + d]; const float z1 = kf[a * 32 + d], z2 = kf[a * 32 + 16 + d];
                        dot += qs[a * 32 + d] * (z1 * cs - z2 * sn) + qs[a * 32 + 16 + d] * (z2 * cs + z1 * sn); }
            } else {
                const float* kp = cache_k + ((((size_t)bl * DEPTH + l) * PAST + (idx - nband)) * 2 + kv) * 64;
#pragma unroll
                for (int c4 = 0; c4 < 16; ++c4) { const f32x4 k4 = *(const f32x4*)(kp + 4 * c4);
                    dot += qs[4 * c4] * k4.x + qs[4 * c4 + 1] * k4.y + qs[4 * c4 + 2] * k4.z + qs[4 * c4 + 3] * k4.w; }
            }
            const float sv = dot * 0.125f; sc[idx] = sv; mx = fmaxf(mx, sv);
        }
        const float sink = attn_sink[l * 8 + hq];
        mx = fmaxf(wave_max(mx), sink);
        float sum = 0.f;
        for (int idx = lane; idx < nkeys; idx += 64) { const float p = expf(sc[idx] - mx); sc[idx] = p; sum += p; }
        const float denom = wave_sum(sum) + expf(sink - mx);
        LDS_WAIT(); asm volatile("" ::: "memory");
        float acc = 0.f;
        for (int idx = 0; idx < nkeys; ++idx) {
            float vv;
            if (!lat || idx < nband) vv = bf2f(QKV[(size_t)(seq0 + j0 + idx) * NIN + 640 + kv * 64 + lane]);
            else vv = cache_v[((((size_t)bl * DEPTH + l) * PAST + (idx - nband)) * 2 + kv) * 64 + lane];
            acc += sc[idx] * vv;
        }
        MIX[(size_t)m * D + hq * 64 + lane] = (bf16)f2bf(acc / denom);
        LDS_WAIT(); asm volatile("" ::: "memory");
    }
    const int cb = m & ~127, p = m & 127;
    for (int h = 0; h < 4; ++h) {
        float r0, r1;
        { float ss0 = 0.f, ss1 = 0.f; const bf16* v0 = QKV + (size_t)(cb + lane) * NIN + 1024 + h * 64; const bf16* v1 = v0 + (size_t)64 * NIN;
#pragma unroll
            for (int c8 = 0; c8 < 8; ++c8) { float a[8], b[8]; load8bf(v0 + 8 * c8, a); load8bf(v1 + 8 * c8, b);
#pragma unroll
                for (int e = 0; e < 8; ++e) { ss0 += a[e] * a[e]; ss1 += b[e] * b[e]; } }
            r0 = 1.0f / sqrtf(ss0 * (1.0f / 64) + EPS); r1 = 1.0f / sqrtf(ss1 * (1.0f / 64) + EPS); }
        const float* wrow = w_spatial + (((size_t)l * 4 + h) * 128 + p) * 128;
        float z = 0.f;
        for (int q = 0; q < 128; ++q) { const float rq = __shfl(q < 64 ? r0 : r1, q & 63);
            z += wrow[q] * (rq * bf2f(QKV[(size_t)(cb + q) * NIN + 1024 + h * 64 + lane])); }
        z += b_spatial[((size_t)l * 4 + h) * 128 + p];
        const float gu = bf2f(qrow[768 + h * 64 + lane]);
        MIX[(size_t)m * D + 512 + h * 64 + lane] = (bf16)f2bf(gu * z);
    }
    for (int g = 0; g < 4; ++g) {
        const int w = 2 << g; const int lo = t - w / 2 < 0 ? 0 : t - w / 2, hi = t + w / 2 > S ? S : t + w / 2;
        float sum = 0.f;
        for (int tt = lo; tt < hi; ++tt) sum += bf2f(QKV[(size_t)(seq0 + tt) * NIN + 1280 + g * 64 + lane]);
        const float dv = sum / (float)(hi - lo) - bf2f(qrow[1280 + g * 64 + lane]);
        const float* wp = w_pool + ((size_t)l * 4 + g) * 64 * 64;
        float o = 0.f;
        for (int i = 0; i < 64; ++i) o += __shfl(dv, i) * wp[i * 64 + lane];
        MIX[(size_t)m * D + 768 + g * 64 + lane] = (bf16)f2bf(o * pool_scale[l * 256 + g * 64 + lane]);
    }
    if (!lat) { const int b = m >> 8; float* ok = F.out + (size_t)M * D + (((size_t)b * DEPTH + l) * SEQ_C + t) * 128; float* ov = ok + (size_t)32 * DEPTH * SEQ_C * 128;
        ok[lane] = bf2f(qrow[512 + lane]); ok[64 + lane] = bf2f(qrow[576 + lane]); ov[lane] = bf2f(qrow[640 + lane]); ov[64 + lane] = bf2f(qrow[704 + lane]); }
}
__device__ __forceinline__ void phase_mix(Frame& F, int l) {
    frame_refresh(F);
    const int gw = F.vcu * NWAVES + F.wave, NGW = F.G * NWAVES;
    for (int m = gw; m < M; m += NGW) mix_row_naive(F, l, m);
}


typedef float f32x16 __attribute__((ext_vector_type(16)));
typedef short s16x4 __attribute__((ext_vector_type(4)));
constexpr int KS_PITCH = 144, VT_PITCH = 136, KBUF_B = 64 * KS_PITCH, VBUF_B = 64 * VT_PITCH;
constexpr int ATT_V_OFF = 2 * KBUF_B;
constexpr float SM_C = 0.125f * 1.4426950408889634f;
__device__ __forceinline__ v4u pack8(const float (&f)[8]) { v4u r; r.x = pk2(f[0], f[1]); r.y = pk2(f[2], f[3]); r.z = pk2(f[4], f[5]); r.w = pk2(f[6], f[7]); return r; }
__device__ __forceinline__ void unpack8(const v4u r, float (&f)[8]) {
    f[0] = __uint_as_float(r.x << 16); f[1] = __uint_as_float(r.x & 0xffff0000u); f[2] = __uint_as_float(r.y << 16); f[3] = __uint_as_float(r.y & 0xffff0000u);
    f[4] = __uint_as_float(r.z << 16); f[5] = __uint_as_float(r.z & 0xffff0000u); f[6] = __uint_as_float(r.w << 16); f[7] = __uint_as_float(r.w & 0xffff0000u);
}
__device__ __forceinline__ unsigned pk2u(unsigned lo, unsigned hi) { return pk2(__uint_as_float(lo), __uint_as_float(hi)); }
__device__ __forceinline__ void load8f(const GAS float* p, float (&f)[8]) { const f32x4 a = *(const GAS f32x4*)p, b = *(const GAS f32x4*)(p + 4); f[0] = a.x; f[1] = a.y; f[2] = a.z; f[3] = a.w; f[4] = b.x; f[5] = b.y; f[6] = b.z; f[7] = b.w; }
__device__ __forceinline__ void vt_store(LAS unsigned char* vb, int key, int c, const v4u r) {
    LAS unsigned short* p = (LAS unsigned short*)(vb + (8 * c) * VT_PITCH + 2 * key);
    p[0 * (VT_PITCH / 2)] = (unsigned short)(r.x & 0xffffu); p[1 * (VT_PITCH / 2)] = (unsigned short)(r.x >> 16); p[2 * (VT_PITCH / 2)] = (unsigned short)(r.y & 0xffffu); p[3 * (VT_PITCH / 2)] = (unsigned short)(r.y >> 16);
    p[4 * (VT_PITCH / 2)] = (unsigned short)(r.z & 0xffffu); p[5 * (VT_PITCH / 2)] = (unsigned short)(r.z >> 16); p[6 * (VT_PITCH / 2)] = (unsigned short)(r.w & 0xffffu); p[7 * (VT_PITCH / 2)] = (unsigned short)(r.w >> 16);
}
__device__ __forceinline__ void attn_unit(Frame& F, int l, bool lat, int u) {
    frame_refresh(F);
    const GAS float* cache_k = (const GAS float*)inp<I_CK>(); const GAS float* cache_v = (const GAS float*)inp<I_CV>();
    const GAS float* ropec = (const GAS float*)P_ROPEC(F); const GAS float* ropes = (const GAS float*)P_ROPES(F);
    const GAS bf16* QKV = (const GAS bf16*)P_QKV(F); GAS bf16* MIX = (GAS bf16*)P_MIX(F);
    const int tid = F.tid, lane = F.lane, wave = F.wave, r32 = lane & 31, hi = lane >> 5;
    LAS unsigned char* lds = F.lds;
    int hq, kv, qrow, qpos = 0, seq0, nband, kt0 = 0, ntiles, bl = 0;
    if (!lat) { const int b = u >> 3; hq = u & 7; kv = hq >> 2; seq0 = b * SEQ_C; qrow = seq0 + wave * 32 + r32; nband = 4; ntiles = 4; }
    else { const int hp = u & 1; kv = (u >> 1) & 1; const int qblk = (u >> 2) & 15; bl = u >> 6; hq = 4 * kv + 2 * hp + (wave >> 2); seq0 = M_CTX + bl * SEQ_L;
        qpos = qblk * 128 + (wave & 3) * 32 + r32; qrow = seq0 + qpos;
        kt0 = qblk * 128 - 128 < 0 ? 0 : qblk * 128 - 128; const int kt1 = qblk * 128 + 256 > SEQ_L ? SEQ_L : qblk * 128 + 256; nband = (kt1 - kt0) >> 6; ntiles = nband + PAST / 64; }
    const float sinkl = inp<I_SINK>()[l * 8 + hq] * 1.4426950408889634f;
    bf16x8 qf[4];
    { const GAS bf16* qp = QKV + (size_t)qrow * NIN + hq * 64 + 8 * hi;
        v4u raw[4];
#pragma unroll
        for (int s = 0; s < 4; ++s) raw[s] = *(const GAS v4u*)(qp + 16 * s);
        if (lat) {
#pragma unroll
            for (int a = 0; a < 2; ++a) { float z1[8], z2[8], cs[8], sn[8]; unpack8(raw[2 * a], z1); unpack8(raw[2 * a + 1], z2);
                const GAS float* cp = ropec + (size_t)qpos * 32 + 16 * a + 8 * hi; const GAS float* sp = ropes + (size_t)qpos * 32 + 16 * a + 8 * hi;
                load8f(cp, cs); load8f(sp, sn);
                float o1[8], o2[8];
#pragma unroll
                for (int e = 0; e < 8; ++e) { o1[e] = z1[e] * cs[e] - z2[e] * sn[e]; o2[e] = z2[e] * cs[e] + z1[e] * sn[e]; }
                raw[2 * a] = pack8(o1); raw[2 * a + 1] = pack8(o2); }
        }
#pragma unroll
        for (int s = 0; s < 4; ++s) qf[s] = __builtin_bit_cast(bf16x8, raw[s]);
    }
    const int skey = tid >> 3, sc = tid & 7;
    v4u kx = {0, 0, 0, 0}, ky = {0, 0, 0, 0}, vx = {0, 0, 0, 0}, wx = {0, 0, 0, 0};
    const GAS float* ckb = cache_k + (((size_t)bl * DEPTH + l) * PAST * 2 + kv) * 64 + 8 * sc;
    const GAS float* cvb = cache_v + (((size_t)bl * DEPTH + l) * PAST * 2 + kv) * 64 + 8 * sc;
    float* ocache = nullptr;
    if (!lat && (hq & 3) == 0) ocache = F.out + (size_t)M * D + (((size_t)(u >> 3) * DEPTH + l) * SEQ_C) * 128 + kv * 64 + 8 * sc;
#define ATT_LOAD(t) do { if ((t) < nband) { const int krow_ = seq0 + kt0 + 64 * (t) + skey; const GAS bf16* kp_ = QKV + (size_t)krow_ * NIN + 512 + kv * 64; \
            kx = *(const GAS v4u*)(kp_ + 8 * sc); if (lat) ky = *(const GAS v4u*)(kp_ + 8 * (sc ^ 2)); vx = *(const GAS v4u*)(kp_ + 128 + 8 * sc); } \
        else { const int key_ = 64 * ((t) - nband) + skey; kx = *(const GAS v4u*)(ckb + (size_t)key_ * 128); ky = *(const GAS v4u*)(ckb + (size_t)key_ * 128 + 4); \
            vx = *(const GAS v4u*)(cvb + (size_t)key_ * 128); wx = *(const GAS v4u*)(cvb + (size_t)key_ * 128 + 4); } } while (0)
#define ATT_STORE(t) do { LAS unsigned char* kb_ = lds + (((t) & 1) ? KBUF_B : 0); LAS unsigned char* vb_ = lds + ATT_V_OFF + (((t) & 1) ? VBUF_B : 0); v4u kw_, vw_; \
        if ((t) < nband) { kw_ = kx; vw_ = vx; \
            if (lat) { const int kt_ = kt0 + 64 * (t) + skey; float x_[8], y_[8], cs_[8], sn_[8]; unpack8(kx, x_); unpack8(ky, y_); \
                const GAS float* cp_ = ropec + (size_t)kt_ * 32 + 16 * (sc >> 2) + 8 * (sc & 1); const GAS float* sp_ = ropes + (size_t)kt_ * 32 + 16 * (sc >> 2) + 8 * (sc & 1); \
                load8f(cp_, cs_); load8f(sp_, sn_); \
                const float sg_ = (sc & 2) ? 1.0f : -1.0f; float o_[8]; \
                _Pragma("unroll") for (int e = 0; e < 8; ++e) o_[e] = x_[e] * cs_[e] + sg_ * (y_[e] * sn_[e]); \
                kw_ = pack8(o_); } \
            if (ocache) { float x_[8], y_[8]; unpack8(kx, x_); unpack8(vx, y_); float* ok_ = ocache + (size_t)(64 * (t) + skey) * 128; float* ov_ = ok_ + (size_t)32 * DEPTH * SEQ_C * 128; \
                *(f32x4*)ok_ = (f32x4){x_[0], x_[1], x_[2], x_[3]}; *(f32x4*)(ok_ + 4) = (f32x4){x_[4], x_[5], x_[6], x_[7]}; *(f32x4*)ov_ = (f32x4){y_[0], y_[1], y_[2], y_[3]}; *(f32x4*)(ov_ + 4) = (f32x4){y_[4], y_[5], y_[6], y_[7]}; } } \
        else { kw_.x = pk2u(kx.x, kx.y); kw_.y = pk2u(kx.z, kx.w); kw_.z = pk2u(ky.x, ky.y); kw_.w = pk2u(ky.z, ky.w); vw_.x = pk2u(vx.x, vx.y); vw_.y = pk2u(vx.z, vx.w); vw_.z = pk2u(wx.x, wx.y); vw_.w = pk2u(wx.z, wx.w); } \
        *(LAS v4u*)(kb_ + skey * KS_PITCH + 16 * sc) = kw_; vt_store(vb_, skey, sc, vw_); } while (0)
    float m_run = sinkl, l_run = hi ? 0.0f : 1.0f;
    f32x16 o0, o1;
#pragma unroll
    for (int r = 0; r < 16; ++r) { o0[r] = 0.f; o1[r] = 0.f; }
    ATT_LOAD(0); ATT_STORE(0);
    LDS_WAIT(); __syncthreads();
    for (int t = 0; t < ntiles; ++t) {
        if (t + 1 < ntiles) ATT_LOAD(t + 1);
        bool active = true, need_mask = false; int k0 = 0;
        if (lat && t < nband) { k0 = kt0 + 64 * t; const int q0 = qpos - r32;
            active = !(k0 + 63 < q0 - 128 || k0 > q0 + 31 + 128); need_mask = !(k0 >= q0 + 31 - 128 && k0 + 63 <= q0 + 128); }
        if (active) {
            const LAS unsigned char* kb = lds + ((t & 1) ? KBUF_B : 0) + r32 * KS_PITCH + 16 * hi; const LAS unsigned char* vb = lds + ATT_V_OFF + ((t & 1) ? VBUF_B : 0) + r32 * VT_PITCH + 8 * hi;
            f32x16 s0, s1;
#pragma unroll
            for (int r = 0; r < 16; ++r) { s0[r] = 0.f; s1[r] = 0.f; }
#pragma unroll
            for (int s = 0; s < 4; ++s) { const bf16x8 a0 = *(const LAS bf16x8*)(kb + 32 * s), a1 = *(const LAS bf16x8*)(kb + 32 * KS_PITCH + 32 * s);
                s0 = __builtin_amdgcn_mfma_f32_32x32x16_bf16(a0, qf[s], s0, 0, 0, 0); s1 = __builtin_amdgcn_mfma_f32_32x32x16_bf16(a1, qf[s], s1, 0, 0, 0); }
            if (need_mask) {
#pragma unroll
                for (int r = 0; r < 16; ++r) { const int kp = k0 + (r & 3) + 8 * (r >> 2) + 4 * hi; const int d0 = qpos - kp, d1 = d0 - 32;
                    if (d0 > 128 || d0 < -128) s0[r] = -INFINITY; if (d1 > 128 || d1 < -128) s1[r] = -INFINITY; } }
            float mx = fmaxf(s0[0], s1[0]);
#pragma unroll
            for (int r = 1; r < 16; ++r) mx = fmaxf(mx, fmaxf(s0[r], s1[r]));
            mx = fmaxf(mx, __shfl_xor(mx, 32));
            const float mnew = fmaxf(m_run, mx * SM_C), alpha = __builtin_amdgcn_exp2f(m_run - mnew); m_run = mnew;
            float ps = 0.f;
#pragma unroll
            for (int r = 0; r < 16; ++r) { s0[r] = __builtin_amdgcn_exp2f(__builtin_fmaf(s0[r], SM_C, -mnew)); s1[r] = __builtin_amdgcn_exp2f(__builtin_fmaf(s1[r], SM_C, -mnew)); ps += s0[r] + s1[r]; o0[r] *= alpha; o1[r] *= alpha; }
            l_run = l_run * alpha + ps;
            v4u pw[4];
            pw[0].x = pk2(s0[0], s0[1]); pw[0].y = pk2(s0[2], s0[3]); pw[0].z = pk2(s0[4], s0[5]); pw[0].w = pk2(s0[6], s0[7]);
            pw[1].x = pk2(s0[8], s0[9]); pw[1].y = pk2(s0[10], s0[11]); pw[1].z = pk2(s0[12], s0[13]); pw[1].w = pk2(s0[14], s0[15]);
            pw[2].x = pk2(s1[0], s1[1]); pw[2].y = pk2(s1[2], s1[3]); pw[2].z = pk2(s1[4], s1[5]); pw[2].w = pk2(s1[6], s1[7]);
            pw[3].x = pk2(s1[8], s1[9]); pw[3].y = pk2(s1[10], s1[11]); pw[3].z = pk2(s1[12], s1[13]); pw[3].w = pk2(s1[14], s1[15]);
#pragma unroll
            for (int ks = 0; ks < 4; ++ks) {
                const s16x4 a_lo = *(const LAS s16x4*)(vb + 32 * ks), a_hi = *(const LAS s16x4*)(vb + 32 * ks + 16);
                const s16x4 b_lo = *(const LAS s16x4*)(vb + 32 * VT_PITCH + 32 * ks), b_hi = *(const LAS s16x4*)(vb + 32 * VT_PITCH + 32 * ks + 16);
                const bf16x8 va = (bf16x8){a_lo[0], a_lo[1], a_lo[2], a_lo[3], a_hi[0], a_hi[1], a_hi[2], a_hi[3]}, vbb = (bf16x8){b_lo[0], b_lo[1], b_lo[2], b_lo[3], b_hi[0], b_hi[1], b_hi[2], b_hi[3]};
                const bf16x8 pf = __builtin_bit_cast(bf16x8, pw[ks]);
                o0 = __builtin_amdgcn_mfma_f32_32x32x16_bf16(va, pf, o0, 0, 0, 0); o1 = __builtin_amdgcn_mfma_f32_32x32x16_bf16(vbb, pf, o1, 0, 0, 0); }
        }
        if (t + 1 < ntiles) ATT_STORE(t + 1);
        LDS_WAIT(); __syncthreads();
    }
#undef ATT_LOAD
#undef ATT_STORE
    const float inv = 1.0f / (l_run + __shfl_xor(l_run, 32));
    GAS bf16* op = MIX + (size_t)qrow * D + hq * 64 + 4 * hi;
#pragma unroll
    for (int g = 0; g < 4; ++g) {
        *(GAS unsigned long long*)(op + 8 * g) = (unsigned long long)pk2(o0[4 * g] * inv, o0[4 * g + 1] * inv) | ((unsigned long long)pk2(o0[4 * g + 2] * inv, o0[4 * g + 3] * inv) << 32);
        *(GAS unsigned long long*)(op + 32 + 8 * g) = (unsigned long long)pk2(o1[4 * g] * inv, o1[4 * g + 1] * inv) | ((unsigned long long)pk2(o1[4 * g + 2] * inv, o1[4 * g + 3] * inv) << 32); }
}

constexpr int VG_PITCH = 272, PL_PITCH = 144, WPT_PITCH = 144, PL_BYTES = 144 * PL_PITCH;
__device__ __forceinline__ void gmlp_unit(Frame& F, int l, int rb, int h) {
    frame_refresh(F);
    const GAS bf16* QKV = (const GAS bf16*)P_QKV(F); GAS bf16* MIX = (GAS bf16*)P_MIX(F);
    const GAS float* w_spatial = (const GAS float*)inp<I_WSP>(); const GAS float* b_spatial = (const GAS float*)inp<I_BSP>();
    const int tid = F.tid, lane = F.lane, wave = F.wave, fr = lane & 15, fq = lane >> 4;
    LAS unsigned char* lds = F.lds;
    const int t0 = rb * 128;
    v4u gvr[2];
#pragma unroll
    for (int i = 0; i < 2; ++i) { const int idx = i * 512 + tid, q = idx >> 3, c = idx & 7; gvr[i] = *(const GAS v4u*)(QKV + (size_t)(t0 + q) * NIN + 1024 + h * 64 + 8 * c); }
    float wf[4][8];
    { const GAS float* wrow = w_spatial + (((size_t)l * 4 + h) * 128 + 16 * wave + fr) * 128 + 8 * fq;
#pragma unroll
        for (int ks = 0; ks < 4; ++ks) load8f(wrow + 32 * ks, wf[ks]); }
    float bs[4], gu[4][4];
#pragma unroll
    for (int reg = 0; reg < 4; ++reg) { const int p = 16 * wave + 4 * fq + reg; bs[reg] = b_spatial[((size_t)l * 4 + h) * 128 + p];
#pragma unroll
        for (int nb = 0; nb < 4; ++nb) gu[reg][nb] = bf2f(QKV[(size_t)(t0 + p) * NIN + 768 + h * 64 + 16 * nb + fr]); }
#pragma unroll
    for (int i = 0; i < 2; ++i) { const int idx = i * 512 + tid, q = idx >> 3, c = idx & 7;
        float v[8]; unpack8(gvr[i], v);
        float ss = 0.f;
#pragma unroll
        for (int e = 0; e < 8; ++e) ss += v[e] * v[e];
        ss += __shfl_xor(ss, 1); ss += __shfl_xor(ss, 2); ss += __shfl_xor(ss, 4);
        const float r = 1.0f / sqrtf(ss * (1.0f / 64) + EPS);
        LAS unsigned short* pw = (LAS unsigned short*)(lds + (8 * c) * VG_PITCH + 2 * q);
#pragma unroll
        for (int e = 0; e < 8; ++e) pw[e * (VG_PITCH / 2)] = (unsigned short)f2bf(v[e] * r); }
    LDS_WAIT(); __syncthreads();
    f32x4 acc[4];
#pragma unroll
    for (int nb = 0; nb < 4; ++nb) acc[nb] = (f32x4){0.f, 0.f, 0.f, 0.f};
#pragma unroll
    for (int ks = 0; ks < 4; ++ks) { const bf16x8 a = __builtin_bit_cast(bf16x8, pack8(wf[ks]));
#pragma unroll
        for (int nb = 0; nb < 4; ++nb) { const bf16x8 b = *(const LAS bf16x8*)(lds + (16 * nb + fr) * VG_PITCH + 64 * ks + 16 * fq);
            acc[nb] = __builtin_amdgcn_mfma_f32_16x16x32_bf16(a, b, acc[nb], 0, 0, 0); } }
#pragma unroll
    for (int reg = 0; reg < 4; ++reg) { const int p = 16 * wave + 4 * fq + reg;
#pragma unroll
        for (int nb = 0; nb < 4; ++nb) MIX[(size_t)(t0 + p) * D + 512 + h * 64 + 16 * nb + fr] = (bf16)f2bf(gu[reg][nb] * (acc[nb][reg] + bs[reg])); }
    LDS_WAIT(); __syncthreads();
}
__device__ __forceinline__ void pool_unit(Frame& F, int l, int rb, int g) {
    frame_refresh(F);
    const GAS bf16* QKV = (const GAS bf16*)P_QKV(F); GAS bf16* MIX = (GAS bf16*)P_MIX(F);
    const GAS float* w_pool = (const GAS float*)inp<I_WPOOL>(); const GAS float* pool_scale = (const GAS float*)inp<I_PSCALE>();
    const int tid = F.tid, lane = F.lane, wave = F.wave, fr = lane & 15, fq = lane >> 4;
    LAS unsigned char* lds = F.lds;
    const int t0 = rb * 128;
    const bool latb = t0 >= M_CTX; const int S = latb ? SEQ_L : SEQ_C; const int seq0 = latb ? M_CTX + (((t0 - M_CTX) >> 11) << 11) : (t0 & ~255); const int p0 = t0 - seq0 - 8;
    v4u plr[3];
#pragma unroll
    for (int i = 0; i < 3; ++i) { const int idx = i * 512 + tid, row = idx >> 3, ch = idx & 7, pos = p0 + row; plr[i] = (v4u){0u, 0u, 0u, 0u};
        if (idx < 1152 && pos >= 0 && pos < S) plr[i] = *(const GAS v4u*)(QKV + (size_t)(seq0 + pos) * NIN + 1280 + g * 64 + 8 * ch); }
    float wp[8]; load8f(w_pool + (((size_t)l * 4 + g) * 64 + (tid >> 3)) * 64 + 8 * (tid & 7), wp);
    float ps[4];
#pragma unroll
    for (int nb = 0; nb < 4; ++nb) ps[nb] = pool_scale[l * 256 + 64 * g + 16 * nb + fr];
#pragma unroll
    for (int i = 0; i < 3; ++i) { const int idx = i * 512 + tid, row = idx >> 3, ch = idx & 7; if (idx < 1152) *(LAS v4u*)(lds + row * PL_PITCH + 16 * ch) = plr[i]; }
    { LAS unsigned short* pw = (LAS unsigned short*)(lds + PL_BYTES + (8 * (tid & 7)) * WPT_PITCH + 2 * (tid >> 3));
#pragma unroll
        for (int e = 0; e < 8; ++e) pw[e * (WPT_PITCH / 2)] = (unsigned short)f2bf(wp[e]); }
    LDS_WAIT(); __syncthreads();
    const int trow = 16 * wave + fr, tpos = t0 - seq0 + trow;
    const int wh = 1 << g; const int lo = tpos - wh < 0 ? 0 : tpos - wh, hi2 = tpos + wh > S ? S : tpos + wh; const float rinv = 1.0f / (float)(hi2 - lo);
    f32x4 acc[4];
#pragma unroll
    for (int nb = 0; nb < 4; ++nb) acc[nb] = (f32x4){0.f, 0.f, 0.f, 0.f};
#pragma unroll
    for (int ks = 0; ks < 2; ++ks) {
        const LAS unsigned char* colp = lds + 2 * (32 * ks + 8 * fq);
        float sum[8];
#pragma unroll
        for (int e = 0; e < 8; ++e) sum[e] = 0.f;
        for (int pp = lo; pp < hi2; ++pp) { float x[8]; unpack8(*(const LAS v4u*)(colp + (pp - p0) * PL_PITCH), x);
#pragma unroll
            for (int e = 0; e < 8; ++e) sum[e] += x[e]; }
        float self[8]; unpack8(*(const LAS v4u*)(colp + (tpos - p0) * PL_PITCH), self);
        float dv[8];
#pragma unroll
        for (int e = 0; e < 8; ++e) dv[e] = sum[e] * rinv - self[e];
        const bf16x8 a = __builtin_bit_cast(bf16x8, pack8(dv));
#pragma unroll
        for (int nb = 0; nb < 4; ++nb) { const bf16x8 b = *(const LAS bf16x8*)(lds + PL_BYTES + (16 * nb + fr) * WPT_PITCH + 64 * ks + 16 * fq);
            acc[nb] = __builtin_amdgcn_mfma_f32_16x16x32_bf16(a, b, acc[nb], 0, 0, 0); } }
#pragma unroll
    for (int nb = 0; nb < 4; ++nb) {
#pragma unroll
        for (int reg = 0; reg < 4; ++reg) MIX[(size_t)(t0 + 16 * wave + 4 * fq + reg) * D + 768 + 64 * g + 16 * nb + fr] = (bf16)f2bf(acc[nb][reg] * ps[nb]); }
    LDS_WAIT(); __syncthreads();
}
__device__ __forceinline__ void small_unit(Frame& F, int l, int s) {
    if (s < 384) gmlp_unit(F, l, s >> 2, s & 3); else pool_unit(F, l, (s - 384) >> 2, s & 3);
}
__device__ __forceinline__ void phase_mix_fast(Frame& F, int l) {
    frame_refresh(F);
    const int v = F.vcu;
    if (F.G == 256) {
        if (v < 128) { attn_unit(F, l, true, v); for (int i = 0; i < 2; ++i) small_unit(F, l, 2 * v + i); }
        else { attn_unit(F, l, false, v - 128); attn_unit(F, l, false, v); for (int i = 0; i < 4; ++i) small_unit(F, l, 256 + 4 * (v - 128) + i); }
    } else {
        for (int u = v; u < 128 + 256 + 768; u += F.G) { if (u < 384) attn_unit(F, l, u < 128, u < 128 ? u : u - 128); else small_unit(F, l, u - 384); }
    }
}

struct Args { const float* in[18]; float* out; unsigned char* ws; int ph_lo, ph_hi, li, pad; };
__global__ void __launch_bounds__(NWAVES * 64, 2) mk_fwd(Args args) {
    extern __shared__ __attribute__((aligned(16))) unsigned char lds[];
    Frame F;
    F.lds = (LAS unsigned char*)lds;
    F.tid = threadIdx.x; F.lane = F.tid & 63; F.wave = __builtin_amdgcn_readfirstlane(F.tid >> 6);
    F.G = gridDim.x; { const int bx = blockIdx.x; F.vcu = (F.G % 8 == 0) ? (bx % 8) * (F.G / 8) + bx / 8 : bx; }
    unsigned char* ws = args.ws;
    F.ws = ws; F.ws0 = ws; F.out = args.out;
    volatile LAS unsigned* MISC = (volatile LAS unsigned*)(F.lds + MISC_OFF);
    for (int u = F.tid; u < (LDS_BYTES - LDSCTL_OFF) / 4; u += NWAVES * 64) ((LAS unsigned*)(F.lds + LDSCTL_OFF))[u] = 0u;
    __syncthreads();
    XcdBarrier bar; bar.bar = (unsigned*)(ws + WS_CTL) + CW_BAR; bar.x = 0; bar.st = nullptr;
    if (N_LAUNCHES == 1) bar = xcd_barrier_post((unsigned*)(ws + WS_CTL) + CW_BAR, MISC + 8);

#define MK_IS_GEMM(ph) ((ph) >= 2 && (((ph) - 2) % 10 == 0 || ((ph) - 2) % 10 == 1 || ((ph) - 2) % 10 == 3 || ((ph) - 2) % 10 == 5 || ((ph) - 2) % 10 == 7 || ((ph) - 2) % 10 == 8))
#define MK_REPEAT(ph) ((MK_PROBE == 1 && MK_IS_GEMM(ph)) || (MK_PROBE == 2 && ((ph) < 2 || ((ph) - 2) % 10 == 4)) || (MK_PROBE == 3 && (ph) >= 2 && ((ph) - 2) % 10 == 4))
    for (int phx = args.ph_lo * 2; phx < args.ph_hi * 2; ++phx) {
        const int ph = phx >> 1;
        if ((phx & 1) && !MK_REPEAT(ph)) continue;
        if (ph == 0) phase_mod(F);
        if (ph == 1) phase_pre(F);
        if (ph >= 2) {
            const int q = ph - 2, l = q / 10, s = q % 10;
            { unsigned char* w_ = F.ws0; asm volatile("" : "+s"(w_)); F.ws = w_; }
            if (s == 0 || s == 7) {
                const int f = (s == 7) ? 1 : 0;
                pg8::Gemm g{P_H(F), P_W1T(F) + (size_t)(l * 2 + f) * (2 * DFF) * D, M, 2 * DFF, D}; pg8::StaticOrder S; S.init(M, 2 * DFF, F.G, (int)blockIdx.x);
                pg8::EpiSwiglu E{P_A(F), DFF};
                pg8::gemm_phase<pg8::EpiSwiglu, pg8::StaticOrder, true, true>(F.lds + RING_OFF, g, S, E);
            } else if (s == 1 || s == 8 || s == 5) {
                const int f = (s == 8) ? 1 : 0;
                pg8::Gemm g{P_A(F), P_W2T(F) + (size_t)(l * 2 + f) * D * DFF, M, D, DFF};
                if (s == 5) { g.A = P_MIX(F); g.Bt = P_WOUT(F) + (size_t)l * D * D; g.K = D; }
                pg8::StaticOrder S; S.init(M, D, F.G, (int)blockIdx.x);
                pg8::EpiF32 E{P_O(F), D};
                pg8::gemm_phase<pg8::EpiF32, pg8::StaticOrder, true, true>(F.lds + RING_OFF, g, S, E);
            } else if (s == 3) {
                pg8::Gemm g{P_H(F), P_WIN(F) + (size_t)l * NIN * D, M, NIN, D}; pg8::StaticOrder S; S.init(M, NIN, F.G, (int)blockIdx.x);
                pg8::EpiBf16P E{P_QKV(F), NIN};
                pg8::gemm_phase<pg8::EpiBf16P, pg8::StaticOrder, true, true>(F.lds + RING_OFF, g, S, E);
            } else if (s == 4) {
#if MK_NAIVE_MIX
                phase_mix(F, l);
#else
                phase_mix_fast(F, l);
#endif
            } else {
                phase_norm(F, l, s);
            }
        }
        if (!(phx & 1) && MK_REPEAT(ph)) { __syncthreads(); continue; }
        if (ph + 1 < args.ph_hi) xcd_barrier(bar);
    }
}

extern "C" void kernel_launch(void* const* d_in, const int* in_sizes, int n_in, void* d_out, int out_size, void* d_ws, size_t ws_size, hipStream_t stream) {
    static int grid = 0;
    if (grid == 0) {
        if (n_in != 18 || ws_size < WS_END) { fprintf(stderr, "kernel_launch: built for 18 inputs and >= %zu bytes of workspace; got n_in %d, ws %zu; nothing launched\n", (size_t)WS_END, n_in, ws_size); grid = -1; return; }
        int dev = 0, cus = 0, per_cu = 0;
        if (hipGetDevice(&dev) != hipSuccess || hipDeviceGetAttribute(&cus, hipDeviceAttributeMultiprocessorCount, dev) != hipSuccess) { fprintf(stderr, "kernel_launch: hipGetDevice / hipDeviceGetAttribute failed\n"); grid = -1; return; }
        if (hipFuncSetAttribute((const void*)mk_fwd, hipFuncAttributeMaxDynamicSharedMemorySize, LDS_BYTES) != hipSuccess) { fprintf(stderr, "kernel_launch: hipFuncSetAttribute failed\n"); grid = -1; return; }
        if (hipOccupancyMaxActiveBlocksPerMultiprocessor(&per_cu, (const void*)mk_fwd, NWAVES * 64, LDS_BYTES) != hipSuccess || per_cu < 1)
            fprintf(stderr, "kernel_launch: note: the occupancy query reports %d workgroups per CU\n", per_cu);
        (void)hipGetLastError();
        grid = cus;
    }
    if (grid < 0) return;
    if (hipMemsetAsync((char*)d_ws + WS_CTL, 0, CTL_ZERO_BYTES, stream) != hipSuccess) { fprintf(stderr, "kernel_launch: hipMemsetAsync failed\n"); return; }
    Args a{};
    for (int i = 0; i < 18; ++i) a.in[i] = (const float*)d_in[i];
    a.out = (float*)d_out; a.ws = (unsigned char*)d_ws;
    for (int li = 0; li < N_LAUNCHES; ++li) {
        a.ph_lo = (N_LAUNCHES == 1) ? 0 : li; a.ph_hi = (N_LAUNCHES == 1) ? NPHASE : li + 1; a.li = li;
        hipLaunchKernelGGL(mk_fwd, dim3(grid), dim3(NWAVES * 64), LDS_BYTES, stream, a);
        const hipError_t le = hipPeekAtLastError();
        if (le != hipSuccess) { fprintf(stderr, "kernel_launch: launch %d failed: %s\n", li, hipGetErrorName(le)); break; }
    }
}
```
